# Optimizing an MI355X kernel written in HIP

```python
import math
import jax, jax.numpy as jnp
from jax import lax
import numpy as np

D_MODEL = 2048
BATCH = 1
SEQ = 8192
DEPTH = 4
DEC_BATCH = 4
DEC_SEQ = 2048
PAST_LEN = 128

HEAD_DIM = 128
NA_HEADS = D_MODEL // HEAD_DIM
NA_WIN_ROWS = 8
NA_WIN_COLS = 16
GRID_W = 64
DIL_CONFIGS = ((128, 1), (512, 4), (2048, 16))
NB_GROUPS = len(DIL_CONFIGS)
NB_HEADS = D_MODEL // HEAD_DIM
T5_BUCKETS = 32
T5_MAX_DIST = 1024
X_HEADS = 4
N_MEM = 256
D_FF = 4 * D_MODEL
N_A_LAYERS = (DEPTH + 1) // 2
N_B_LAYERS = DEPTH // 2
RMS_EPS = 1e-6
NEG_INF = -1e30
ATTN_SCALE = 1.0 / math.sqrt(HEAD_DIM)

kernel_name = "hybrid_natten_dilated_encoder"


def rmsnorm(x, g):
    x32 = x.astype(jnp.float32)
    y = x32 * lax.rsqrt(jnp.mean(x32 * x32, axis=-1, keepdims=True) + RMS_EPS)
    return (y * g.astype(jnp.float32)).astype(x.dtype)


def t5_bucket(rel):
    nb = T5_BUCKETS // 2
    max_exact = nb // 2
    ret = jnp.where(rel > 0, nb, 0)
    n = jnp.abs(rel)
    n_f = jnp.maximum(n, 1).astype(jnp.float32)
    large = max_exact + (jnp.log(n_f / max_exact) / math.log(T5_MAX_DIST / max_exact)
                         * (nb - max_exact)).astype(jnp.int32)
    large = jnp.minimum(large, nb - 1)
    return ret + jnp.where(n < max_exact, n, large)


def neighborhood_mixer(h, w_qkv, qn, kn, rpb, w_o):
    bn, s, _ = h.shape
    rows = s // GRID_W
    kh = min(NA_WIN_ROWS, rows)
    qkv = (h @ w_qkv).reshape(bn, s, 3, NA_HEADS, HEAD_DIM)
    q = rmsnorm(qkv[:, :, 0], qn)
    k = rmsnorm(qkv[:, :, 1], kn)
    v = qkv[:, :, 2]
    r = jnp.arange(rows)
    rs = jnp.clip(r - kh // 2, 0, rows - kh)
    key_rows = rs[:, None] + jnp.arange(kh)[None, :]
    c = jnp.arange(GRID_W)
    cs = jnp.clip(c - NA_WIN_COLS // 2, 0, GRID_W - NA_WIN_COLS)
    col_ok = (c[None, :] >= cs[:, None]) & (c[None, :] < cs[:, None] + NA_WIN_COLS)
    qg = q.reshape(bn, rows, GRID_W, NA_HEADS, HEAD_DIM)
    kg = k.reshape(bn, rows, GRID_W, NA_HEADS, HEAD_DIM)[:, key_rows].reshape(bn, rows, kh * GRID_W, NA_HEADS, HEAD_DIM)
    vg = v.reshape(bn, rows, GRID_W, NA_HEADS, HEAD_DIM)[:, key_rows].reshape(bn, rows, kh * GRID_W, NA_HEADS, HEAD_DIM)
    logits = jnp.einsum('brqhd,brkhd->brhqk', qg, kg).astype(jnp.float32) * ATTN_SCALE
    dr = key_rows - r[:, None] + (NA_WIN_ROWS - 1)
    dc = jnp.clip(c[None, :] - c[:, None], -(NA_WIN_COLS - 1), NA_WIN_COLS - 1) + (NA_WIN_COLS - 1)
    bias = rpb[:, dr][..., dc]
    bias = bias.transpose(1, 0, 3, 2, 4).reshape(rows, NA_HEADS, GRID_W, kh * GRID_W)
    mask = jnp.tile(col_ok, (1, kh))
    logits = jnp.where(mask, logits + bias.astype(jnp.float32)[None], NEG_INF)
    p = jax.nn.softmax(logits, axis=-1).astype(v.dtype)
    o = jnp.einsum('brhqk,brkhd->brqhd', p, vg).reshape(bn, s, NA_HEADS * HEAD_DIM)
    return o @ w_o


def dilated_group_attn(q, k, v, t5_g, dil, radius):
    bn, s, nh, dh = q.shape
    L = s // dil
    n = bn * dil

    def to_res(t):
        return t.reshape(bn, L, dil, nh, dh).transpose(0, 2, 1, 3, 4).reshape(n, L, nh, dh)

    q, k, v = to_res(q), to_res(k), to_res(v)
    blk = radius
    nb = -(-L // blk)
    lp = nb * blk
    qp = jnp.pad(q, ((0, 0), (0, lp - L), (0, 0), (0, 0))).reshape(n, nb, blk, nh, dh)

    def windows(t):
        tp = jnp.pad(t, ((0, 0), (radius, lp - L + radius), (0, 0), (0, 0))).reshape(n, nb + 2, blk, nh, dh)
        return jnp.concatenate([tp[:, :nb], tp[:, 1:nb + 1], tp[:, 2:nb + 2]], axis=2)

    kw, vw = windows(k), windows(v)
    i = jnp.arange(blk)
    j = jnp.arange(3 * blk)
    dm = j[None, :] - blk - i[:, None]
    key_idx = jnp.arange(nb)[:, None] * blk - radius + j[None, :]
    valid = (jnp.abs(dm) <= radius)[None] & ((key_idx >= 0) & (key_idx < L))[:, None, :]
    bias = t5_g[t5_bucket(dm * dil)].transpose(2, 0, 1).astype(jnp.float32)
    logits = jnp.einsum('nbqhd,nbkhd->nbhqk', qp, kw).astype(jnp.float32) * ATTN_SCALE + bias[None, None]
    logits = jnp.where(valid[None, :, None], logits, NEG_INF)
    m = jnp.max(logits, axis=-1, keepdims=True)
    p = jnp.exp(logits - m)
    den = jnp.sum(p, axis=-1, keepdims=True)
    o = jnp.einsum('nbhqk,nbkhd->nbqhd', (p / den).astype(v.dtype), vw)
    lse = (m + jnp.log(den))[..., 0].transpose(0, 1, 3, 2)
    o = o.reshape(n, lp, nh, dh)[:, :L]
    lse = lse.reshape(n, lp, nh)[:, :L]
    o = o.reshape(bn, dil, L, nh, dh).transpose(0, 2, 1, 3, 4).reshape(bn, s, nh, dh)
    lse = lse.reshape(bn, dil, L, nh).transpose(0, 2, 1, 3).reshape(bn, s, nh)
    return o, lse


def dilated_mixer(h, w_qkv, qn, kn, t5_table, w_o):
    bn, s, _ = h.shape
    qkv = (h @ w_qkv).reshape(bn, s, NB_GROUPS, 3, NB_HEADS, HEAD_DIM)
    outs, lses = [], []
    for g, (window, dil) in enumerate(DIL_CONFIGS):
        q = rmsnorm(qkv[:, :, g, 0], qn[g])
        k = rmsnorm(qkv[:, :, g, 1], kn[g])
        v = qkv[:, :, g, 2]
        o, lse = dilated_group_attn(q, k, v, t5_table[:, g], dil, window // (2 * dil))
        outs.append(o)
        lses.append(lse)
    wts = jax.nn.softmax(jnp.stack(lses, axis=0), axis=0)
    o = jnp.sum(wts[..., None].astype(outs[0].dtype) * jnp.stack(outs, axis=0), axis=0)
    return o.reshape(bn, s, NB_HEADS * HEAD_DIM) @ w_o


def memory_cross_attn(h, mem_n, w_q, w_kv, qn, kn, w_o):
    bn, s, _ = h.shape
    nm = mem_n.shape[1]
    q = rmsnorm((h @ w_q).reshape(bn, s, X_HEADS, HEAD_DIM), qn)
    kv = (mem_n @ w_kv).reshape(bn, nm, 2, X_HEADS, HEAD_DIM)
    k = rmsnorm(kv[:, :, 0], kn)
    v = kv[:, :, 1]
    logits = jnp.einsum('bshd,bmhd->bhsm', q, k).astype(jnp.float32) * ATTN_SCALE
    p = jax.nn.softmax(logits, axis=-1).astype(v.dtype)
    o = jnp.einsum('bhsm,bmhd->bshd', p, v).reshape(bn, s, X_HEADS * HEAD_DIM)
    return o @ w_o


def sqrelu_mlp(h, w_up, w_down):
    a = jax.nn.relu(h @ w_up)
    return (a * a) @ w_down


def trunk(x, mem, g_mix, g_cross, g_mem, g_mlp, w_qkv_a, q_norm_a, k_norm_a, rpb_a, w_o_a,
          w_qkv_b, q_norm_b, k_norm_b, t5_table, w_o_b, w_q_x, w_kv_x, q_norm_x, k_norm_x, w_o_x,
          w_up, w_down):
    for i in range(DEPTH):
        h = rmsnorm(x, g_mix[i])
        li = i // 2
        if i % 2 == 0:
            x = x + neighborhood_mixer(h, w_qkv_a[li], q_norm_a[li], k_norm_a[li], rpb_a[li], w_o_a[li])
        else:
            x = x + dilated_mixer(h, w_qkv_b[li], q_norm_b[li], k_norm_b[li], t5_table, w_o_b[li])
        h = rmsnorm(x, g_cross[i])
        m = rmsnorm(mem, g_mem[i])
        x = x + memory_cross_attn(h, m, w_q_x[i], w_kv_x[i], q_norm_x[i], k_norm_x[i], w_o_x[i])
        h = rmsnorm(x, g_mlp[i])
        x = x + sqrelu_mlp(h, w_up[i], w_down[i])
    return x


def setup_inputs(seed: int = 0) -> dict:
    key = jax.random.key(seed)
    ks = jax.random.split(key, 32)

    def nrm(k, shape, scale):
        return jax.random.normal(k, shape, jnp.float32) * scale

    def gain(k, shape):
        return 1.0 + nrm(k, shape, 0.05)

    d = D_MODEL
    return {
        "x_prompt": nrm(ks[0], (BATCH, SEQ, d), 1.0),
        "x_sample": nrm(ks[1], (DEC_BATCH, DEC_SEQ, d), 1.0),
        "mem_prompt": nrm(ks[2], (BATCH, N_MEM, d), 1.0),
        "mem_sample": nrm(ks[3], (DEC_BATCH, N_MEM, d), 1.0),
        "g_mix": gain(ks[4], (DEPTH, d)),
        "g_cross": gain(ks[5], (DEPTH, d)),
        "g_mem": gain(ks[6], (DEPTH, d)),
        "g_mlp": gain(ks[7], (DEPTH, d)),
        "w_qkv_a": nrm(ks[8], (N_A_LAYERS, d, 3 * NA_HEADS * HEAD_DIM), d ** -0.5),
        "q_norm_a": gain(ks[9], (N_A_LAYERS, HEAD_DIM)),
        "k_norm_a": gain(ks[10], (N_A_LAYERS, HEAD_DIM)),
        "rpb_a": nrm(ks[11], (N_A_LAYERS, NA_HEADS, 2 * NA_WIN_ROWS - 1, 2 * NA_WIN_COLS - 1), 0.1),
        "w_o_a": nrm(ks[12], (N_A_LAYERS, NA_HEADS * HEAD_DIM, d), (NA_HEADS * HEAD_DIM) ** -0.5),
        "w_qkv_b": nrm(ks[13], (N_B_LAYERS, d, NB_GROUPS * 3 * NB_HEADS * HEAD_DIM), d ** -0.5),
        "q_norm_b": gain(ks[14], (N_B_LAYERS, NB_GROUPS, HEAD_DIM)),
        "k_norm_b": gain(ks[15], (N_B_LAYERS, NB_GROUPS, HEAD_DIM)),
        "t5_table": nrm(ks[16], (T5_BUCKETS, NB_GROUPS, NB_HEADS), 0.1),
        "w_o_b": nrm(ks[17], (N_B_LAYERS, NB_HEADS * HEAD_DIM, d), (NB_HEADS * HEAD_DIM) ** -0.5),
        "w_q_x": nrm(ks[18], (DEPTH, d, X_HEADS * HEAD_DIM), d ** -0.5),
        "w_kv_x": nrm(ks[19], (DEPTH, d, 2 * X_HEADS * HEAD_DIM), d ** -0.5),
        "q_norm_x": gain(ks[20], (DEPTH, HEAD_DIM)),
        "k_norm_x": gain(ks[21], (DEPTH, HEAD_DIM)),
        "w_o_x": nrm(ks[22], (DEPTH, X_HEADS * HEAD_DIM, d), (X_HEADS * HEAD_DIM) ** -0.5),
        "w_up": nrm(ks[23], (DEPTH, d, D_FF), d ** -0.5),
        "w_down": nrm(ks[24], (DEPTH, D_FF, d), D_FF ** -0.5),
    }


def reference(x_prompt, x_sample, mem_prompt, mem_sample, g_mix, g_cross, g_mem, g_mlp,
              w_qkv_a, q_norm_a, k_norm_a, rpb_a, w_o_a, w_qkv_b, q_norm_b, k_norm_b, t5_table, w_o_b,
              w_q_x, w_kv_x, q_norm_x, k_norm_x, w_o_x, w_up, w_down):
    y_prompt = trunk(x_prompt, mem_prompt, g_mix, g_cross, g_mem, g_mlp, w_qkv_a, q_norm_a, k_norm_a,
                     rpb_a, w_o_a, w_qkv_b, q_norm_b, k_norm_b, t5_table, w_o_b, w_q_x, w_kv_x,
                     q_norm_x, k_norm_x, w_o_x, w_up, w_down)
    y_sample = trunk(x_sample, mem_sample, g_mix, g_cross, g_mem, g_mlp, w_qkv_a, q_norm_a, k_norm_a,
                     rpb_a, w_o_a, w_qkv_b, q_norm_b, k_norm_b, t5_table, w_o_b, w_q_x, w_kv_x,
                     q_norm_x, k_norm_x, w_o_x, w_up, w_down)
    return (y_prompt, y_sample)
```

```cpp
#include <hip/hip_runtime.h>
#include <cstdio>
#include <cstdint>
namespace pg8 {
#define PG8_LAS __attribute__((address_space(3)))
typedef unsigned short bf16_t;
typedef short bf16x8 __attribute__((ext_vector_type(8)));
typedef float f32x4 __attribute__((ext_vector_type(4)));
typedef unsigned u32x4 __attribute__((ext_vector_type(4)));
constexpr int BM = 256, BK = 64, HALF = 128, HTB = HALF * BK * 2  , STAGE_BYTES = 8 * HTB, NXCD = 8, WGM = 4;

__host__ __device__ __forceinline__ int lds_byte(int r, int c) { const int st = (r >> 4) * 2 + (c >> 5), rr = r & 15, cc = c & 31, ob = rr * 64 + cc * 2; return st * 1024 + (ob ^ (((ob >> 9) & 1) << 5)); }
__host__ __device__ __forceinline__ void stage_rc(int b, int& R, int& C) { const int st = b / 1024, sb = b % 1024, swz = sb ^ (((sb >> 9) & 1) << 5); R = (st >> 1) * 16 + swz / 64; C = (st & 1) * 32 + (swz % 64) / 2; }
__host__ __device__ __forceinline__ int perm32(int rho) { const int n = rho >> 4, i = rho & 15; return 8 * (i >> 2) + 4 * n + (i & 3); }

struct Unit { int pm, pn, ko; };
struct Gemm { const bf16_t* A; const bf16_t* Bt; int M, N, K, ld; };

struct StaticOrder {
    int nM, nN, nwg, G, c, wgm;
    __host__ __device__ void init(int M, int N, int G_, int c_, int wgm_ = WGM) { nM = M / BM; nN = N / BM; nwg = nM * nN; G = G_; c = c_; wgm = wgm_; }
    __host__ __device__ bool next(int i, Unit& u) const {
        const long L = (long)i * G + c; if (L >= nwg) return false;
        int wgid = (int)L; { const int q = nwg / NXCD, r = nwg % NXCD, xcd = wgid % NXCD, off = wgid / NXCD; wgid = (xcd < r ? xcd * (q + 1) : r * (q + 1) + (xcd - r) * q) + off; }
        const int nig = wgm * nN, gid = wgid / nig, fm = gid * wgm, gsz = (nM - fm) < wgm ? (nM - fm) : wgm;
        u.pm = fm + ((wgid % nig) % gsz); u.pn = (wgid % nig) / gsz; u.ko = 0; return true;
    }
    __device__ __forceinline__ void a_ready(const Unit&) const {}
    __device__ __forceinline__ void done(const Unit&) const {}
};

__device__ __forceinline__ unsigned cvt_pk_bf16(float lo, float hi) { unsigned r; asm volatile("v_cvt_pk_bf16_f32 %0, %1, %2" : "=v"(r) : "v"(lo), "v"(hi)); return r; }
typedef float f32x2 __attribute__((ext_vector_type(2)));
typedef unsigned u32x2 __attribute__((ext_vector_type(2)));
template <int ACT> struct EpiBf16 {
    static constexpr bool PERM = true, AFTER_DRAIN = false; static_assert(ACT == 0 || ACT == 2, "EpiBf16: ACT is 0 (none) or 2 (squared relu)");
    bf16_t* O; int ldc; int split_cols; size_t split_stride; size_t ko_stride;
    __device__ __forceinline__ void operator()(const f32x4 (&acc)[2][2][4][2], const Unit& u, int wr, int wc, int fr, int fq) const {
        const int row0 = u.pm * BM + wr * 64 + fr; int colt = u.pn * BM; bf16_t* base = O;
        if (split_cols) { const int t = colt / split_cols; base += (size_t)t * split_stride; colt -= t * split_cols; }
        if (u.ko) base += ko_stride;
        const int col0 = colt + wc * 32 + 8 * fq;
#pragma unroll
        for (int ai = 0; ai < 2; ++ai)
#pragma unroll
            for (int m = 0; m < 4; ++m) { bf16_t* rowp = base + (size_t)(row0 + ai * HALF + m * 16) * ldc + col0;
#pragma unroll
                for (int bj = 0; bj < 2; ++bj) { f32x4 v0 = acc[ai][bj][m][0], v1 = acc[ai][bj][m][1];
                    if (ACT == 2) {
#pragma unroll
                        for (int e = 0; e < 4; ++e) { const float a = fmaxf(v0[e], 0.f), b = fmaxf(v1[e], 0.f); v0[e] = a * a; v1[e] = b * b; } }
                    u32x4 w; w.x = cvt_pk_bf16(v0[0], v0[1]); w.y = cvt_pk_bf16(v0[2], v0[3]); w.z = cvt_pk_bf16(v1[0], v1[1]); w.w = cvt_pk_bf16(v1[2], v1[3]);
                    *(u32x4*)(rowp + bj * HALF) = w; } }
    }
};
struct EpiRes {
    static constexpr bool PERM = true, AFTER_DRAIN = false;
    bf16_t* xb; float* outf; int ldc; unsigned long long* ssout; const unsigned long long* ssin;
    __device__ __forceinline__ void operator()(const f32x4 (&acc)[2][2][4][2], const Unit& u, int wr, int wc, int fr, int fq) const {
        const int row0 = u.pm * BM + wr * 64 + fr, col0 = u.pn * BM + wc * 32 + 8 * fq;
        float sq[2][4];
#pragma unroll
        for (int ai = 0; ai < 2; ++ai) {
            u32x4 b[4][2]; unsigned long long sv[4];
#pragma unroll
            for (int m = 0; m < 4; ++m) { const bf16_t* bp = xb + (size_t)(row0 + ai * HALF + m * 16) * ldc + col0;
#pragma unroll
                for (int bj = 0; bj < 2; ++bj) b[m][bj] = *(const u32x4*)(bp + bj * HALF);
                sv[m] = ssin ? ssin[row0 + ai * HALF + m * 16] : 0ull; }
#pragma unroll
            for (int m = 0; m < 4; ++m) { const int row = row0 + ai * HALF + m * 16; bf16_t* xp = xb + (size_t)row * ldc + col0;
                const float sc = ssin ? 1.0f / ((float)sv[m] * (1.f / (16777216.f * 2048.f)) + 1e-6f) : 1.f;
                float q = 0.f;
#pragma unroll
                for (int bj = 0; bj < 2; ++bj) { f32x4 v0, v1;
#pragma unroll
                    for (int e = 0; e < 2; ++e) { v0[2 * e] = __builtin_bit_cast(float, b[m][bj][e] << 16); v0[2 * e + 1] = __builtin_bit_cast(float, b[m][bj][e] & 0xffff0000u);
                                                  v1[2 * e] = __builtin_bit_cast(float, b[m][bj][2 + e] << 16); v1[2 * e + 1] = __builtin_bit_cast(float, b[m][bj][2 + e] & 0xffff0000u); }
                    v0 += acc[ai][bj][m][0] * sc; v1 += acc[ai][bj][m][1] * sc;
                    q += ((v0[0] * v0[0] + v0[1] * v0[1]) + (v0[2] * v0[2] + v0[3] * v0[3])) + ((v1[0] * v1[0] + v1[1] * v1[1]) + (v1[2] * v1[2] + v1[3] * v1[3]));
                    if (outf) { float* op = outf + (size_t)row * ldc + col0 + bj * HALF; *(f32x4*)op = v0; *(f32x4*)(op + 4) = v1; }
                    else { u32x4 w; w.x = cvt_pk_bf16(v0[0], v0[1]); w.y = cvt_pk_bf16(v0[2], v0[3]); w.z = cvt_pk_bf16(v1[0], v1[1]); w.w = cvt_pk_bf16(v1[2], v1[3]); *(u32x4*)(xp + bj * HALF) = w; } }
                sq[ai][m] = q; }
            asm volatile("" ::: "memory");
        }
#pragma unroll
        for (int ai = 0; ai < 2; ++ai) {
#pragma unroll
            for (int m = 0; m < 4; ++m) { float q = sq[ai][m]; q += __shfl_xor(q, 16); q += __shfl_xor(q, 32); sq[ai][m] = q; }
            const float v = fq == 0 ? sq[ai][0] : (fq == 1 ? sq[ai][1] : (fq == 2 ? sq[ai][2] : sq[ai][3]));
            atomicAdd(ssout + (u.pm * BM + wr * 64 + ai * HALF + fq * 16 + fr), (unsigned long long)(v * 16777216.f)); }
    }
};

struct EpiQKV {
    static constexpr bool PERM = true, AFTER_DRAIN = false; static constexpr int NS = 16;
    bf16_t* O; int ldc; const PG8_LAS float* varl; PG8_LAS float* red; int pm0, pm1; const unsigned long long* ss; const PG8_LAS float* gql;
    __device__ __forceinline__ void operator()(const f32x4 (&acc)[2][2][4][2], const Unit& u, int wr, int wc, int fr, int fq) const {
        const int row0 = u.pm * BM + wr * 64 + fr, col0 = u.pn * BM + wc * 32 + 8 * fq;
        const int kind = u.pn >> 3;
        float sc[2][2][4];
#pragma unroll
        for (int ai = 0; ai < 2; ++ai)
#pragma unroll
            for (int bj = 0; bj < 2; ++bj)
#pragma unroll
                for (int m = 0; m < 4; ++m) sc[ai][bj][m] = 1.f;
        {
            float var[2][4];
            const int slot = u.pm == pm0 ? 0 : (u.pm == pm1 ? 1 : -1);
#pragma unroll
            for (int ai = 0; ai < 2; ++ai)
#pragma unroll
                for (int m = 0; m < 4; ++m) { const int rl = ai * HALF + wr * 64 + m * 16 + fr;
                    var[ai][m] = slot >= 0 ? varl[slot * BM + rl] : (float)ss[u.pm * BM + rl] * (1.f / (16777216.f * 2048.f)) + 1e-6f; }
            if (kind != 2) {
#pragma unroll
                for (int ai = 0; ai < 2; ++ai)
#pragma unroll
                    for (int bj = 0; bj < 2; ++bj)
#pragma unroll
                        for (int m = 0; m < 4; ++m) { const f32x4 a = acc[ai][bj][m][0], b = acc[ai][bj][m][1];
                            float q = ((a[0] * a[0] + a[1] * a[1]) + (a[2] * a[2] + a[3] * a[3])) + ((b[0] * b[0] + b[1] * b[1]) + (b[2] * b[2] + b[3] * b[3]));
                            q += __shfl_xor(q, 16); q += __shfl_xor(q, 32);
                            if (fq == 0) red[((ai * HALF + wr * 64 + m * 16 + fr) * 2 + bj) * 4 + wc] = q; }
                asm volatile("s_waitcnt lgkmcnt(0)" ::: "memory");
                __builtin_amdgcn_s_barrier();
#pragma unroll
                for (int ai = 0; ai < 2; ++ai)
#pragma unroll
                    for (int bj = 0; bj < 2; ++bj)
#pragma unroll
                        for (int m = 0; m < 4; ++m) { const f32x4 r4 = *(const PG8_LAS f32x4*)(red + ((ai * HALF + wr * 64 + m * 16 + fr) * 2 + bj) * 4);
                            sc[ai][bj][m] = __builtin_amdgcn_rsqf(((r4[0] + r4[1]) + (r4[2] + r4[3])) * (1.f / 128.f) + 1e-6f * var[ai][m]); }
            } else {
#pragma unroll
                for (int ai = 0; ai < 2; ++ai)
#pragma unroll
                    for (int m = 0; m < 4; ++m) { const float r = __builtin_amdgcn_rsqf(var[ai][m]); sc[ai][0][m] = r; sc[ai][1][m] = r; }
            }
        }
        if (kind == 0) {
            const f32x4 g0 = *(const PG8_LAS f32x4*)(gql + wc * 32 + 8 * fq), g1 = *(const PG8_LAS f32x4*)(gql + wc * 32 + 8 * fq + 4);
#pragma unroll
            for (int ai = 0; ai < 2; ++ai)
#pragma unroll
                for (int m = 0; m < 4; ++m) { bf16_t* rowp = O + (size_t)(row0 + ai * HALF + m * 16) * ldc + col0;
#pragma unroll
                    for (int bj = 0; bj < 2; ++bj) { const f32x4 v0 = acc[ai][bj][m][0] * sc[ai][bj][m] * g0, v1 = acc[ai][bj][m][1] * sc[ai][bj][m] * g1;
                        u32x4 w; w.x = cvt_pk_bf16(v0[0], v0[1]); w.y = cvt_pk_bf16(v0[2], v0[3]); w.z = cvt_pk_bf16(v1[0], v1[1]); w.w = cvt_pk_bf16(v1[2], v1[3]);
                        *(u32x4*)(rowp + bj * HALF) = w; } }
        } else {
#pragma unroll
            for (int ai = 0; ai < 2; ++ai)
#pragma unroll
                for (int m = 0; m < 4; ++m) { bf16_t* rowp = O + (size_t)(row0 + ai * HALF + m * 16) * ldc + col0;
#pragma unroll
                    for (int bj = 0; bj < 2; ++bj) { const f32x4 v0 = acc[ai][bj][m][0] * sc[ai][bj][m], v1 = acc[ai][bj][m][1] * sc[ai][bj][m];
                        u32x4 w; w.x = cvt_pk_bf16(v0[0], v0[1]); w.y = cvt_pk_bf16(v0[2], v0[3]); w.z = cvt_pk_bf16(v1[0], v1[1]); w.w = cvt_pk_bf16(v1[2], v1[3]);
                        *(u32x4*)(rowp + bj * HALF) = w; } }
        }
    }
};
template <class Epi, class Sched, bool ALIGN_EPI = false, bool SP2 = false>
__device__ __forceinline__ void gemm_phase(PG8_LAS unsigned char* lds, const Gemm g, const Sched& S, const Epi& E) {
    int tid_l = threadIdx.x; asm volatile("" : "+v"(tid_l));
    const int tid = tid_l, wid = __builtin_amdgcn_readfirstlane(tid >> 6), lane = tid & 63, wr = wid >> 2, wc = wid & 3, fr = lane & 15, fq = lane >> 4;
    const int K = g.K, nt = K / BK, LD = g.ld ? g.ld : g.K;
    unsigned voffA[2], voffB[2];
#pragma unroll
    for (int i = 0; i < 2; ++i) { int R, C; stage_rc(tid * 16 + i * 8192, R, C); const int Rb = Epi::PERM ? ((R & ~31) + perm32(R & 31)) : R;
        voffA[i] = (unsigned)(R * LD + C) * 2u; voffB[i] = (unsigned)(Rb * LD + C) * 2u; }
    const size_t kstep = (size_t)(BK * 2);
    const size_t hstep = (size_t)HALF * LD * 2;
    const size_t tstep = 2 * hstep;
    const unsigned ldsw = (unsigned)wid * 1024u;
    const int aoff = lds_byte(wr * 64 + fr, fq * 8), boff = lds_byte(wc * 32 + fr, fq * 8);
#define PG8_SA(b, h) (((b) * 2 + (h)) * HTB)
#define PG8_SB(b, h) ((4 + (b) * 2 + (h)) * HTB)
#define PG8_STAGE(bufoff, gbase, voff) do { _Pragma("unroll") for (int _i = 0; _i < 2; ++_i) \
        __builtin_amdgcn_global_load_lds((const unsigned*)((const char*)(gbase) + (voff)[_i]), (PG8_LAS unsigned*)(lds + (bufoff) + ldsw + _i * 8192), 16, 0, 0); } while (0)
#define PG8_LDA(dst, b, h) do { _Pragma("unroll") for (int m = 0; m < 4; ++m) _Pragma("unroll") for (int k = 0; k < 2; ++k) dst[m][k] = *(const PG8_LAS bf16x8*)(lds + PG8_SA(b, h) + aoff + m * 2048 + k * 1024); } while (0)
#define PG8_LDB(dst, b, h) do { _Pragma("unroll") for (int n = 0; n < 2; ++n) _Pragma("unroll") for (int k = 0; k < 2; ++k) dst[n][k] = *(const PG8_LAS bf16x8*)(lds + PG8_SB(b, h) + boff + n * 2048 + k * 1024); } while (0)
#define PG8_MMA(ai, bj, At, Bt) do { __builtin_amdgcn_s_setprio(1); _Pragma("unroll") for (int m = 0; m < 4; ++m) _Pragma("unroll") for (int n = 0; n < 2; ++n) _Pragma("unroll") for (int k = 0; k < 2; ++k) \
        acc[ai][bj][m][n] = __builtin_amdgcn_mfma_f32_16x16x32_bf16(Bt[n][k], At[m][k], acc[ai][bj][m][n], 0, 0, 0); __builtin_amdgcn_s_setprio(0); } while (0)
#define PG8_WAIT_V(n) asm volatile("s_waitcnt vmcnt(" #n ")" ::: "memory")
#define PG8_WAIT_L(n) asm volatile("s_waitcnt lgkmcnt(" #n ")" ::: "memory")
#define PG8_BAR __builtin_amdgcn_s_barrier()
#define PG8_SCHED __builtin_amdgcn_sched_barrier(0)
    Unit cur, nxt; int ui = 0;
    if (!S.next(0, cur)) return;
    f32x4 acc[2][2][4][2];
#pragma unroll
    for (int a = 0; a < 2; ++a)
#pragma unroll
        for (int b = 0; b < 2; ++b)
#pragma unroll
            for (int m = 0; m < 4; ++m)
#pragma unroll
                for (int n = 0; n < 2; ++n) acc[a][b][m][n] = (f32x4){0.f, 0.f, 0.f, 0.f};
    bf16x8 At[4][2], B0[2][2], B1[2][2];
    const char* cA = (const char*)g.A + (size_t)cur.pm * tstep + (size_t)cur.ko * 2; const char* cB = (const char*)g.Bt + (size_t)cur.pn * tstep + (size_t)cur.ko * 2;
    S.a_ready(cur);
    if constexpr (SP2) {
        PG8_STAGE(PG8_SB(0, 0), cB, voffB); PG8_STAGE(PG8_SB(0, 1), cB + hstep, voffB); PG8_STAGE(PG8_SA(0, 0), cA, voffA); PG8_STAGE(PG8_SA(0, 1), cA + hstep, voffA);
        if (wr == 1) PG8_BAR;
        PG8_WAIT_V(2); PG8_BAR;
        PG8_STAGE(PG8_SB(1, 0), cB + kstep, voffB); PG8_STAGE(PG8_SA(1, 0), cA + kstep, voffA); PG8_STAGE(PG8_SB(1, 1), cB + hstep + kstep, voffB);
        PG8_WAIT_V(6); PG8_BAR;
    } else {
        PG8_STAGE(PG8_SB(0, 0), cB, voffB); PG8_STAGE(PG8_SA(0, 0), cA, voffA); PG8_STAGE(PG8_SB(0, 1), cB + hstep, voffB); PG8_STAGE(PG8_SA(0, 1), cA + hstep, voffA);
        if (wr == 1) PG8_BAR;
        PG8_WAIT_V(4); PG8_BAR;
        PG8_STAGE(PG8_SB(1, 0), cB + kstep, voffB); PG8_STAGE(PG8_SA(1, 0), cA + kstep, voffA); PG8_STAGE(PG8_SB(1, 1), cB + hstep + kstep, voffB);
        PG8_WAIT_V(6); PG8_BAR;
    }
    for (;;) {
        const bool has_next = S.next(ui + 1, nxt);
        const char* nA = has_next ? (const char*)g.A + (size_t)nxt.pm * tstep + (size_t)nxt.ko * 2 : cA; const char* nB = has_next ? (const char*)g.Bt + (size_t)nxt.pn * tstep + (size_t)nxt.ko * 2 : cB;
        for (int t = 0; t < nt; t += 2) {
            const bool last = (t == nt - 2);
            const char* a1 = cA + (size_t)(t + 1) * kstep;
            const char* a2 = last ? nA : cA + (size_t)(t + 2) * kstep; const char* b2 = last ? nB : cB + (size_t)(t + 2) * kstep;
            const char* a3 = a2 + kstep; const char* b3 = b2 + kstep;
            if (last && has_next) S.a_ready(nxt);
            if constexpr (SP2) {
            PG8_LDB(B0, 0, 0); PG8_LDB(B1, 0, 1); PG8_SCHED; PG8_LDA(At, 0, 0); PG8_STAGE(PG8_SA(1, 1), a1 + hstep, voffA);
            PG8_WAIT_V(8); PG8_WAIT_L(0); PG8_BAR; PG8_MMA(0, 0, At, B0); PG8_MMA(0, 1, At, B1); PG8_BAR; PG8_SCHED;
            PG8_LDA(At, 0, 1); PG8_STAGE(PG8_SB(0, 0), b2, voffB); PG8_STAGE(PG8_SB(0, 1), b2 + hstep, voffB); PG8_STAGE(PG8_SA(0, 0), a2, voffA);
            PG8_WAIT_V(8); PG8_WAIT_L(0); PG8_BAR; PG8_MMA(1, 0, At, B0); PG8_MMA(1, 1, At, B1); PG8_BAR; PG8_SCHED;
            PG8_LDB(B0, 1, 0); PG8_LDB(B1, 1, 1); PG8_SCHED; PG8_LDA(At, 1, 0); PG8_STAGE(PG8_SA(0, 1), a2 + hstep, voffA);
            PG8_WAIT_V(8); PG8_WAIT_L(0); PG8_BAR; PG8_MMA(0, 0, At, B0); PG8_MMA(0, 1, At, B1); PG8_BAR; PG8_SCHED;
            PG8_LDA(At, 1, 1); PG8_STAGE(PG8_SB(1, 0), b3, voffB); PG8_STAGE(PG8_SB(1, 1), b3 + hstep, voffB); PG8_STAGE(PG8_SA(1, 0), a3, voffA);
            PG8_WAIT_V(8); PG8_WAIT_L(0); PG8_BAR; PG8_MMA(1, 0, At, B0); PG8_MMA(1, 1, At, B1); PG8_BAR; PG8_SCHED;
            } else {
            PG8_LDB(B0, 0, 0); PG8_SCHED; PG8_LDA(At, 0, 0); PG8_STAGE(PG8_SA(1, 1), a1 + hstep, voffA);
            PG8_WAIT_L(8); PG8_BAR; PG8_WAIT_L(0); PG8_MMA(0, 0, At, B0); PG8_BAR; PG8_SCHED;
            PG8_LDB(B1, 0, 1); PG8_STAGE(PG8_SB(0, 0), b2, voffB);
            PG8_BAR; PG8_WAIT_L(0); PG8_MMA(0, 1, At, B1); PG8_BAR;
            PG8_LDA(At, 0, 1); PG8_STAGE(PG8_SA(0, 0), a2, voffA);
            PG8_BAR; PG8_WAIT_L(0); PG8_MMA(1, 0, At, B0); PG8_BAR; PG8_SCHED;
            PG8_STAGE(PG8_SB(0, 1), b2 + hstep, voffB);
            PG8_WAIT_V(6); PG8_BAR; PG8_MMA(1, 1, At, B1); PG8_BAR;
            PG8_LDB(B0, 1, 0); PG8_SCHED; PG8_LDA(At, 1, 0); PG8_STAGE(PG8_SA(0, 1), a2 + hstep, voffA);
            PG8_WAIT_L(8); PG8_BAR; PG8_WAIT_L(0); PG8_MMA(0, 0, At, B0); PG8_BAR; PG8_SCHED;
            PG8_LDB(B1, 1, 1); PG8_STAGE(PG8_SB(1, 0), b3, voffB);
            PG8_BAR; PG8_WAIT_L(0); PG8_MMA(0, 1, At, B1); PG8_BAR;
            PG8_LDA(At, 1, 1); PG8_STAGE(PG8_SA(1, 0), a3, voffA);
            PG8_BAR; PG8_WAIT_L(0); PG8_MMA(1, 0, At, B0); PG8_BAR; PG8_SCHED;
            PG8_STAGE(PG8_SB(1, 1), b3 + hstep, voffB);
            PG8_WAIT_V(6); PG8_BAR; PG8_MMA(1, 1, At, B1); PG8_BAR;
            }
        }
        if constexpr (ALIGN_EPI) { if (wr == 0) PG8_BAR; }
        if constexpr (!Epi::AFTER_DRAIN) { E(acc, cur, wr, wc, fr, fq); S.done(cur); }
        if (!has_next) break;
#pragma unroll
        for (int a = 0; a < 2; ++a)
#pragma unroll
            for (int b = 0; b < 2; ++b)
#pragma unroll
                for (int m = 0; m < 4; ++m)
#pragma unroll
                    for (int n = 0; n < 2; ++n) acc[a][b][m][n] = (f32x4){0.f, 0.f, 0.f, 0.f};
        cur = nxt; cA = nA; cB = nB; ++ui;
        if constexpr (ALIGN_EPI) { if (wr == 1) PG8_BAR; }
    }
    PG8_WAIT_V(0);
    if constexpr (!ALIGN_EPI) { if (wr == 0) PG8_BAR; }
    PG8_BAR;
    if constexpr (Epi::AFTER_DRAIN) { E.fused(acc, cur, wr, wc, fr, fq, lds, wid, lane); S.done(cur); }
#undef PG8_SA
#undef PG8_SB
#undef PG8_STAGE
#undef PG8_LDA
#undef PG8_LDB
#undef PG8_MMA
#undef PG8_WAIT_V
#undef PG8_WAIT_L
#undef PG8_BAR
#undef PG8_SCHED
}
}
constexpr int NWAVES = 8;
constexpr int DM = 2048, MTOK = 16384, DFF = 8192, HD = 128, NHEAD = 16, XHEAD = 4, NMEM = 256;
constexpr int S_P = 8192, S_S = 2048;
constexpr int MEMROWS = 5 * NMEM;
constexpr int NQKV = 3 * DM;
constexpr float RMS_EPS = 1e-6f;
constexpr float ATTN_SCALE = 0.08838834764831845f;
constexpr float LOG2E = 1.4426950408889634f;

constexpr size_t MiB = 1u << 20;
constexpr size_t WS_CTL = 0, CTL_ZERO_BYTES = 1 * MiB;
constexpr size_t WS_LSE = 1 * MiB;
constexpr size_t WS_SS = 4 * MiB;
typedef unsigned long long u64;
constexpr float SS_SCALE = 16777216.f, SS_INV = 1.f / (16777216.f * 2048.f);
constexpr size_t WS_WQKVA = 16 * MiB;
constexpr size_t WS_WQKVB = 64 * MiB;
constexpr size_t WS_WOA = 208 * MiB, WS_WOB = 224 * MiB;
constexpr size_t WS_WQX = 240 * MiB;
constexpr size_t WS_WKVX = 248 * MiB;
constexpr size_t WS_WOX = 264 * MiB;
constexpr size_t WS_WUP = 272 * MiB;
constexpr size_t WS_WDN = 400 * MiB;
constexpr size_t WS_H = 528 * MiB;
constexpr size_t WS_O = 592 * MiB;
constexpr size_t WS_XQ = 656 * MiB, WS_XO = 672 * MiB;
constexpr size_t WS_KVM = 688 * MiB;
constexpr size_t WS_QKV = 704 * MiB;
constexpr size_t WS_OG = 896 * MiB;
constexpr size_t WS_HID = 704 * MiB;
constexpr size_t WS_XQ2 = 1088 * MiB;
constexpr size_t WS_END = 1104 * MiB;
constexpr int CW_BAR = 4096;

constexpr int RING_OFF = 0, RING_BYTES = 131072;
constexpr int LDSCTL_OFF = RING_BYTES, MISC_OFF = LDSCTL_OFF + 320;
constexpr int LDS_BYTES = 147456;

#define GAS __attribute__((address_space(1)))
#define LAS __attribute__((address_space(3)))
typedef unsigned short bf16;
typedef unsigned v4u __attribute__((ext_vector_type(4)));
typedef unsigned v2u __attribute__((ext_vector_type(2)));
typedef float f32x4 __attribute__((ext_vector_type(4)));
typedef GAS unsigned gu32;
#define LDS_WAIT() asm volatile("s_waitcnt lgkmcnt(0)" ::: "memory")
#define VM_WAIT() asm volatile("s_waitcnt vmcnt(0)" ::: "memory")
__device__ __forceinline__ unsigned f2bf(float f) { unsigned u = __builtin_bit_cast(unsigned, f); return (u + 0x7fffu + ((u >> 16) & 1u)) >> 16; }
__device__ __forceinline__ unsigned pk2(float lo, float hi) { return f2bf(lo) | (f2bf(hi) << 16); }
__device__ __forceinline__ float bflo(unsigned w) { return __builtin_bit_cast(float, w << 16); }
__device__ __forceinline__ float bfhi(unsigned w) { return __builtin_bit_cast(float, w & 0xffff0000u); }
__device__ __forceinline__ float wave_sum(float v) {
#pragma unroll
    for (int o = 1; o < 64; o <<= 1) v += __shfl_xor(v, o);
    return v;
}
__device__ __forceinline__ float wave_max(float v) {
#pragma unroll
    for (int o = 1; o < 64; o <<= 1) v = fmaxf(v, __shfl_xor(v, o));
    return v;
}
__device__ __forceinline__ void seq_of(int m, int& sb, int& len) { if (m < S_P) { sb = 0; len = S_P; } else { sb = S_P + ((m - S_P) & ~(S_S - 1)); len = S_S; } }

#define XB_TMO      128
#define XB_XCNT(j)  (256  + 64 * (j))
#define XB_XSUB(j)  (1280 + 64 * (j))
#define XB_XGEN(j)  (2304 + 64 * (j))
#define XB_TOP      3328
#define XB_TOPGEN   3392
#define XCD_BAR_WORDS 3456
#define XB_SPIN_CAP (1u << 18)

__device__ __forceinline__ unsigned xb_ld(unsigned* p)              { return __hip_atomic_load(p, __ATOMIC_RELAXED, __HIP_MEMORY_SCOPE_AGENT); }
__device__ __forceinline__ unsigned xb_add(unsigned* p, unsigned v) { return __hip_atomic_fetch_add(p, v, __ATOMIC_RELAXED, __HIP_MEMORY_SCOPE_AGENT); }
__device__ __forceinline__ unsigned xb_xcc_id() { return (unsigned)__builtin_amdgcn_s_getreg((3 << 11) | 20) & 0xFu; }
#define XB_SPIN(cond, bar) do { unsigned _sp = 0; while (cond) { __builtin_amdgcn_s_sleep(1); \
    if ((++_sp & 255u) == 0u) { if (xb_ld(&(bar)[XB_TMO])) break; if (_sp > XB_SPIN_CAP) { atomicAdd(&(bar)[XB_TMO], 1u); break; } } } } while (0)

struct XcdBarrier {
    unsigned* bar; unsigned x;
    volatile LAS unsigned* st;
};

__device__ __forceinline__ XcdBarrier xcd_barrier_post(unsigned* bar, volatile LAS unsigned* st) {
    XcdBarrier b; b.bar = bar; b.x = xb_xcc_id(); b.st = st;
    if (threadIdx.x == 0) (void)xb_add(&bar[XB_XCNT(b.x)], 1u);
    return b;
}
__device__ __forceinline__ void xcd_barrier_complete(unsigned* bar, unsigned x, unsigned& nloc, unsigned& nx) {
    const unsigned G = gridDim.x * gridDim.y * gridDim.z;
    unsigned sum, cnt, mine, sp = 0u;
    for (;;) {
        sum = 0u; cnt = 0u; mine = 0u;
#pragma unroll
        for (unsigned j = 0; j < 16; ++j) { const unsigned c = xb_ld(&bar[XB_XCNT(j)]); sum += c; cnt += (c > 0u) ? 1u : 0u; mine = (j == x) ? c : mine; }
        if (sum == G) break;
        __builtin_amdgcn_s_sleep(1);
        if ((++sp & 255u) == 0u) { if (xb_ld(&bar[XB_TMO])) break; if (sp > XB_SPIN_CAP) { atomicAdd(&bar[XB_TMO], 1u); break; } }
    }
    nloc = mine > 0u ? mine : 1u; nx = cnt > 0u ? cnt : 1u;
}

__device__ __forceinline__ void xcd_barrier(const XcdBarrier& b) {
    asm volatile("s_waitcnt vmcnt(0)" ::: "memory");
    __syncthreads();
    if (threadIdx.x == 0) {
        unsigned* bar = b.bar;
        __builtin_amdgcn_s_waitcnt(0);
        unsigned nloc = b.st[0], nx = b.st[1];
        if (nloc == 0u) { xcd_barrier_complete(bar, b.x, nloc, nx); b.st[0] = nloc; b.st[1] = nx; }
        const unsigned old = xb_add(&bar[XB_XSUB(b.x)], 1u);
        const unsigned gen = old / nloc;
        if (old + 1u == (gen + 1u) * nloc) {
            __builtin_amdgcn_fence(__ATOMIC_RELEASE, "agent");
            asm volatile("s_waitcnt vmcnt(0)" ::: "memory");
            const unsigned og = xb_add(&bar[XB_TOP], 1u);
            const unsigned tg = og / nx;
            if (og + 1u == (tg + 1u) * nx) xb_add(&bar[XB_TOPGEN], 1u);
            else XB_SPIN(xb_ld(&bar[XB_TOPGEN]) == tg, bar);
            __builtin_amdgcn_fence(__ATOMIC_ACQUIRE, "agent");
            xb_add(&bar[XB_XGEN(b.x)], 1u);
            asm volatile("s_waitcnt vmcnt(0)" ::: "memory");
        } else {
            XB_SPIN(xb_ld(&bar[XB_XGEN(b.x)]) == gen, bar);
            __builtin_amdgcn_fence(__ATOMIC_ACQUIRE, "agent");
            asm volatile("s_waitcnt vmcnt(0)" ::: "memory");
        }
    }
    __syncthreads();
}

__device__ __forceinline__ void transpose_item(const float* W, const float* g  , int K, int N, bf16* WT, LAS float* scr, int kb, int nb, int lane) {
    const int k0 = 64 * kb, n0 = 32 * nb;
#pragma unroll 8
    for (int i = 0; i < 32; ++i) { const int kk = 2 * i + (lane >> 5); const float gv = g ? g[k0 + kk] : 1.f; scr[kk * 33 + (lane & 31)] = W[(size_t)(k0 + kk) * N + n0 + (lane & 31)] * gv; }
    LDS_WAIT(); asm volatile("" ::: "memory");
    const int c = lane & 7;
#pragma unroll
    for (int j = 0; j < 4; ++j) { const int n = (lane >> 3) + 8 * j; const LAS float* s = scr + (8 * c) * 33 + n;
        v4u o; o.x = pk2(s[0 * 33], s[1 * 33]); o.y = pk2(s[2 * 33], s[3 * 33]); o.z = pk2(s[4 * 33], s[5 * 33]); o.w = pk2(s[6 * 33], s[7 * 33]);
        *(GAS v4u*)(WT + (size_t)(n0 + n) * K + k0 + 8 * c) = o; }
    LDS_WAIT(); asm volatile("" ::: "memory");
}
__device__ __forceinline__ void transpose_tensor(const float* W, const float* g, int gstep, int nl, int K, int N, bf16* WT, LAS float* scr, int gw, int NGW, int lane) {
    const int nblk = N / 32, per = (K / 64) * nblk, total = nl * per;
    for (int it = gw; it < total; it += NGW) { const int l = it / per, r = it - l * per;
        transpose_item(W + (size_t)l * K * N, g ? g + (size_t)l * gstep : nullptr, K, N, WT + (size_t)l * K * N, scr, r / nblk, r % nblk, lane); }
}
__device__ __forceinline__ void rms_row_to_bf16(const float* xrow, const float* g, bf16* orow, int lane) {
    const GAS f32x4* xr = (const GAS f32x4*)xrow + lane; const GAS f32x4* gr = (const GAS f32x4*)g + lane;
    f32x4 v[8]; float s = 0.f;
#pragma unroll
    for (int j = 0; j < 8; ++j) { v[j] = xr[64 * j]; s += (v[j].x * v[j].x + v[j].y * v[j].y) + (v[j].z * v[j].z + v[j].w * v[j].w); }
    const float rstd = 1.0f / sqrtf(wave_sum(s) * (1.f / DM) + RMS_EPS);
    GAS v2u* o8 = (GAS v2u*)orow + lane;
#pragma unroll
    for (int j = 0; j < 8; ++j) { const f32x4 gv = gr[64 * j]; v2u o; o.x = pk2(v[j].x * rstd * gv.x, v[j].y * rstd * gv.y); o.y = pk2(v[j].z * rstd * gv.z, v[j].w * rstd * gv.w); o8[64 * j] = o; }
}
__device__ __forceinline__ void row_to_bf16_ss(const float* xrow, bf16* orow, u64* ss, int lane) {
    const GAS f32x4* xr = (const GAS f32x4*)xrow + lane; f32x4 v[8]; float s = 0.f;
#pragma unroll
    for (int j = 0; j < 8; ++j) { v[j] = xr[64 * j]; s += (v[j].x * v[j].x + v[j].y * v[j].y) + (v[j].z * v[j].z + v[j].w * v[j].w); }
    s = wave_sum(s);
    GAS v2u* o8 = (GAS v2u*)orow + lane;
#pragma unroll
    for (int j = 0; j < 8; ++j) { v2u o; o.x = pk2(v[j].x, v[j].y); o.y = pk2(v[j].z, v[j].w); o8[64 * j] = o; }
    if (lane == 0) *ss = (u64)(s * SS_SCALE);
}
__device__ __forceinline__ void norm_phase(const float* x0, const float* x1, int sub1, const float* g, bf16* H, int gw, int NGW, int lane) {
    for (int m = gw; m < MTOK; m += NGW) { const float* xr = (m < S_P) ? x0 + (size_t)m * DM : x1 + (size_t)(m - sub1) * DM; rms_row_to_bf16(xr, g, H + (size_t)m * DM, lane); }
}
__device__ __forceinline__ void merge_phase(const bf16* OG, const float* LSE, bf16* O, int gtid, int NT) {
    for (int idx = gtid; idx < MTOK * (DM / 8); idx += NT) {
        const int m = idx >> 8, col = (idx & 255) * 8, h = col >> 7;
        const float l0 = LSE[(size_t)m * 16 + h], l1 = LSE[(size_t)MTOK * 16 + (size_t)m * 16 + h], l2 = LSE[(size_t)2 * MTOK * 16 + (size_t)m * 16 + h];
        const float mx = fmaxf(l0, fmaxf(l1, l2)); float w0 = __expf(l0 - mx), w1 = __expf(l1 - mx), w2 = __expf(l2 - mx); const float inv = 1.f / (w0 + w1 + w2); w0 *= inv; w1 *= inv; w2 *= inv;
        const size_t off = (size_t)m * DM + col;
        const v4u a = *(const GAS v4u*)(OG + off), b = *(const GAS v4u*)(OG + (size_t)MTOK * DM + off), c = *(const GAS v4u*)(OG + (size_t)2 * MTOK * DM + off);
        v4u o;
#pragma unroll
        for (int e = 0; e < 4; ++e) { const float lo = w0 * bflo(a[e]) + w1 * bflo(b[e]) + w2 * bflo(c[e]), hi = w0 * bfhi(a[e]) + w1 * bfhi(b[e]) + w2 * bfhi(c[e]); o[e] = pk2(lo, hi); }
        *(GAS v4u*)(O + off) = o;
    }
}

__device__ const unsigned char T5B[3][132] = {
 {11,11,11,11,11,11,11,11,11,11,11,11,11,11,11,10,10,10,10,10,10,10,10,10,10,10,10,10,10,10,10,10,10,10,10,10,10,10,9,9,9,9,9,9,9,9,9,9,9,9,8,8,8,8,8,8,8,7,6,5,4,3,2,1,0,17,18,19,20,21,22,23,24,24,24,24,24,24,24,25,25,25,25,25,25,25,25,25,25,25,25,26,26,26,26,26,26,26,26,26,26,26,26,26,26,26,26,26,26,26,26,26,26,26,27,27,27,27,27,27,27,27,27,27,27,27,27,27,27,0,0,0},
 {13,13,13,13,13,13,13,13,13,13,13,13,13,13,13,13,13,13,13,13,13,13,13,12,12,12,12,12,12,12,12,12,12,12,12,12,12,12,12,12,12,12,11,11,11,11,11,11,11,11,11,11,10,10,10,10,10,10,9,9,9,8,8,4,0,20,24,24,25,25,25,26,26,26,26,26,26,27,27,27,27,27,27,27,27,27,27,28,28,28,28,28,28,28,28,28,28,28,28,28,28,28,28,28,28,28,29,29,29,29,29,29,29,29,29,29,29,29,29,29,29,29,29,29,29,29,29,29,29,0,0,0},
 {15,15,15,15,15,15,15,15,15,15,15,15,15,15,15,15,15,15,15,15,15,15,15,15,15,15,15,15,15,15,14,14,14,14,14,14,14,14,14,14,14,14,14,14,14,13,13,13,13,13,13,13,13,13,12,12,12,12,12,11,11,10,10,9,0,25,26,26,27,27,28,28,28,28,28,29,29,29,29,29,29,29,29,29,30,30,30,30,30,30,30,30,30,30,30,30,30,30,30,31,31,31,31,31,31,31,31,31,31,31,31,31,31,31,31,31,31,31,31,31,31,31,31,31,31,31,31,31,31,0,0,0}};

struct NaiveNA {
    static constexpr int NHEADS = NHEAD, NCAND = 128;
    const bf16* Q; const bf16* K; const bf16* V; int ld; const float* qn; const float* kn; const float* rpb  ; bf16* O; int ldo; float* lse;
    __device__ __forceinline__ void cand(int m, int h, int j, int& ktok, float& bias, bool& valid) const {
        int sb, len; seq_of(m, sb, len); const int pos = m - sb, rows = len >> 6, r = pos >> 6, c = pos & 63;
        int rs = r - 4; rs = rs < 0 ? 0 : (rs > rows - 8 ? rows - 8 : rs); int cs = c - 8; cs = cs < 0 ? 0 : (cs > 48 ? 48 : cs);
        const int kr = rs + (j >> 4), kc = cs + (j & 15); ktok = sb + kr * 64 + kc;
        int dc = kc - c; dc = dc < -15 ? -15 : (dc > 15 ? 15 : dc);
        bias = rpb[(h * 15 + (kr - r + 7)) * 31 + dc + 15]; valid = j < NCAND;
        if (!valid) { ktok = m; bias = 0.f; }
    }
};
struct NaiveDil {
    static constexpr int NHEADS = NHEAD, NCAND = 129;
    const bf16* Q; const bf16* K; const bf16* V; int ld; const float* qn; const float* kn; const float* t5  ; int g, dil; bf16* O; int ldo; float* lse;
    __device__ __forceinline__ void cand(int m, int h, int j, int& ktok, float& bias, bool& valid) const {
        int sb, len; seq_of(m, sb, len); const int pos = m - sb, t = pos / dil, rho = pos - t * dil, L = len / dil;
        const int kt = t + j - 64; valid = (j < NCAND) && kt >= 0 && kt < L; ktok = valid ? sb + kt * dil + rho : m;
        bias = valid ? t5[(int)T5B[g][j] * 48 + g * 16 + h] : 0.f;
    }
};
struct NaiveX {
    static constexpr int NHEADS = XHEAD, NCAND = 256;
    const bf16* Q; const bf16* K; const bf16* V; int ld  ; const float* qn; const float* kn; bf16* O; int ldo; float* lse; int ldq;
    __device__ __forceinline__ void cand(int m, int h, int j, int& ktok, float& bias, bool& valid) const {
        const int b = m < S_P ? 0 : 1 + ((m - S_P) >> 11); ktok = b * NMEM + j; bias = 0.f; valid = true;
    }
};
template <class P, int LDQ> __device__ __forceinline__ void attn_naive(const P& p, int gw, int NGW, int lane) {
    constexpr int NC = (P::NCAND + 63) / 64;
    for (int task = gw; task < MTOK * P::NHEADS; task += NGW) {
        const int m = task / P::NHEADS, h = task - m * P::NHEADS;
        const unsigned qw = *(const GAS unsigned*)(p.Q + (size_t)m * LDQ + h * HD + 2 * lane);
        float q0 = bflo(qw), q1 = bfhi(qw);
        const float rq = 1.0f / sqrtf(wave_sum(q0 * q0 + q1 * q1) * (1.f / HD) + RMS_EPS);
        q0 *= rq * p.qn[2 * lane] * p.kn[2 * lane] * ATTN_SCALE; q1 *= rq * p.qn[2 * lane + 1] * p.kn[2 * lane + 1] * ATTN_SCALE;
        int kt[NC]; float bias[NC], sc[NC]; bool valid[NC];
#pragma unroll
        for (int c = 0; c < NC; ++c) { p.cand(m, h, lane + 64 * c, kt[c], bias[c], valid[c]); sc[c] = 0.f; }
#pragma unroll
        for (int c = 0; c < NC; ++c) {
            const int nj = (P::NCAND - 64 * c) < 64 ? (P::NCAND - 64 * c) : 64;
            for (int jj = 0; jj < nj; ++jj) {
                const int ktok = __shfl(kt[c], jj);
                const unsigned kw = *(const GAS unsigned*)(p.K + (size_t)ktok * p.ld + h * HD + 2 * lane);
                const float k0 = bflo(kw), k1 = bfhi(kw);
                const float dot = wave_sum(q0 * k0 + q1 * k1), kss = wave_sum(k0 * k0 + k1 * k1);
                const float s = dot * (1.0f / sqrtf(kss * (1.f / HD) + RMS_EPS));
                if (lane == jj) sc[c] = s;
            }
        }
        float mx = -3.0e38f;
#pragma unroll
        for (int c = 0; c < NC; ++c) { sc[c] = valid[c] ? sc[c] + bias[c] : -1e30f; mx = fmaxf(mx, sc[c]); }
        mx = wave_max(mx); float l = 0.f;
#pragma unroll
        for (int c = 0; c < NC; ++c) { sc[c] = valid[c] ? __expf(sc[c] - mx) : 0.f; l += sc[c]; }
        l = wave_sum(l); const float inv = 1.f / l;
        float o0 = 0.f, o1 = 0.f;
#pragma unroll
        for (int c = 0; c < NC; ++c) {
            const int nj = (P::NCAND - 64 * c) < 64 ? (P::NCAND - 64 * c) : 64;
            for (int jj = 0; jj < nj; ++jj) {
                const int ktok = __shfl(kt[c], jj); const float pj = __shfl(sc[c], jj) * inv;
                const unsigned vw = *(const GAS unsigned*)(p.V + (size_t)ktok * p.ld + h * HD + 2 * lane);
                o0 += pj * bflo(vw); o1 += pj * bfhi(vw);
            }
        }
        *(GAS unsigned*)(p.O + (size_t)m * p.ldo + h * HD + 2 * lane) = pk2(o0, o1);
        if (p.lse != nullptr && lane == 0) p.lse[(size_t)m * 16 + h] = mx + __logf(l);
    }
}

namespace at {
using bf16x8 = __attribute__((ext_vector_type(8))) short;
using s16x4  = __attribute__((ext_vector_type(4))) short;
using f32x16 = __attribute__((ext_vector_type(16))) float;
using u32x4  = __attribute__((ext_vector_type(4))) unsigned;
#define KSWZ(row, colB) ((row) * 256 + ((colB) ^ (((row) & 7) << 4)))
#define SBAR() __builtin_amdgcn_sched_barrier(0)
constexpr int SHM_V = 16384, SHM_K = 16384;
constexpr int A_V = 0, A_K = 2 * SHM_V, A_OST = 65536;
constexpr int A_WS = LDSCTL_OFF + 1024, A_GQ = A_WS + 8 * 256, A_TB = A_GQ + 512, A_TB0 = A_TB + 256;
static_assert(A_TB0 + 4 * 640 <= LDS_BYTES, "attention LDS map");
constexpr float NEGM = -1e30f;
__device__ __forceinline__ int crow(int r, int hi) { return (r & 3) + 8 * (r >> 2) + 4 * hi; }
__device__ __forceinline__ unsigned cvtpk(float lo, float hi) { unsigned r; asm volatile("v_cvt_pk_bf16_f32 %0, %1, %2" : "=v"(r) : "v"(lo), "v"(hi)); return r; }
__device__ __forceinline__ float pl32_max(float v) { auto rr = __builtin_amdgcn_permlane32_swap(__float_as_uint(v), __float_as_uint(v), false, false); return fmaxf(__uint_as_float(rr[0]), __uint_as_float(rr[1])); }
__device__ __forceinline__ float pl32_sum(float v) { auto rr = __builtin_amdgcn_permlane32_swap(__float_as_uint(v), __float_as_uint(v), false, false); return __uint_as_float(rr[0]) + __uint_as_float(rr[1]); }
__device__ __forceinline__ int v_st(int k, int c) { const int kk = (k & ~0xC) | ((k & 4) << 1) | ((k & 8) >> 1); return ((kk >> 3) * 4 + (c >> 5)) * 512 + ((kk & 7) * 32 + (c & 31)) * 2; }
__device__ __forceinline__ int v_rd_base(int lane) { return ((lane & 3) << 3) | (((lane >> 2) & 3) << 6) | (((lane >> 4) & 1) << 5) | (((lane >> 5) & 1) << 8); }
constexpr int v_rd_off(int d0, int ks, int half) { return d0 * 512 + ks * 4096 + half * 2048; }
template <int OFF> __device__ __forceinline__ s16x4 tr_read(int vb) { s16x4 r; asm volatile("ds_read_b64_tr_b16 %0, %1 offset:%2" : "=&v"(r) : "v"(vb), "i"(OFF) : "memory"); return r; }
template <int D0> __device__ __forceinline__ void pv_one(f32x16& od, int vb, bf16x8 pa0, bf16x8 pa1, bf16x8 pa2, bf16x8 pa3) {
  const s16x4 l0 = tr_read<v_rd_off(D0, 0, 0)>(vb), h0 = tr_read<v_rd_off(D0, 0, 1)>(vb), l1 = tr_read<v_rd_off(D0, 1, 0)>(vb), h1 = tr_read<v_rd_off(D0, 1, 1)>(vb);
  const s16x4 l2 = tr_read<v_rd_off(D0, 2, 0)>(vb), h2 = tr_read<v_rd_off(D0, 2, 1)>(vb), l3 = tr_read<v_rd_off(D0, 3, 0)>(vb), h3 = tr_read<v_rd_off(D0, 3, 1)>(vb);
  asm volatile("s_waitcnt lgkmcnt(0)" ::: "memory"); SBAR();
#define PK(L, H) (bf16x8){L[0], L[1], L[2], L[3], H[0], H[1], H[2], H[3]}
  od = __builtin_amdgcn_mfma_f32_32x32x16_bf16(pa0, PK(l0, h0), od, 0, 0, 0);
  od = __builtin_amdgcn_mfma_f32_32x32x16_bf16(pa1, PK(l1, h1), od, 0, 0, 0);
  od = __builtin_amdgcn_mfma_f32_32x32x16_bf16(pa2, PK(l2, h2), od, 0, 0, 0);
  od = __builtin_amdgcn_mfma_f32_32x32x16_bf16(pa3, PK(l3, h3), od, 0, 0, 0);
#undef PK
}
__device__ __forceinline__ void qkt(f32x16& p0, f32x16& p1, const LAS unsigned char* Ks, const bf16x8 (&qf)[8], int r32, int hi) {
  bf16x8 kb0[2], kb1[2]; int kx[4];
#pragma unroll
  for (int k = 0; k < 4; ++k) kx[k] = KSWZ(r32, (k * 16 + hi * 8) * 2);
#define QKT_LOAD(d0_, s_) do { const LAS unsigned char* kp_ = Ks + kx[(d0_) & 3] + ((d0_) >> 2) * 128; kb0[s_] = *(const LAS bf16x8*)kp_; kb1[s_] = *(const LAS bf16x8*)(kp_ + 8192); } while (0)
  QKT_LOAD(0, 0); QKT_LOAD(1, 1);
  SBAR();
#pragma unroll
  for (int d0 = 0; d0 < 8; ++d0) { const int sl = d0 & 1;
    p0 = __builtin_amdgcn_mfma_f32_32x32x16_bf16(kb0[sl], qf[d0], p0, 0, 0, 0); p1 = __builtin_amdgcn_mfma_f32_32x32x16_bf16(kb1[sl], qf[d0], p1, 0, 0, 0);
    SBAR();
    if (d0 + 2 < 8) { QKT_LOAD(d0 + 2, sl); SBAR(); } }
#undef QKT_LOAD
}
template <int CTRL> __device__ __forceinline__ float dppf(float v) { return __builtin_bit_cast(float, __builtin_amdgcn_update_dpp(0, __builtin_bit_cast(int, v), CTRL, 0xf, 0xf, true)); }
__device__ __forceinline__ float row16_sum(float v) { v += dppf<0xB1>(v); v += dppf<0x4E>(v); v += dppf<0x141>(v); v += dppf<0x140>(v); return v; }
__device__ __forceinline__ u32x4 knorm(u32x4 w, float epsv) {
  float f[8]; float ss = 0.f;
#pragma unroll
  for (int e = 0; e < 4; ++e) { f[2 * e] = bflo(w[e]); f[2 * e + 1] = bfhi(w[e]); ss += f[2 * e] * f[2 * e] + f[2 * e + 1] * f[2 * e + 1]; }
  ss = row16_sum(ss);
  const float rs = __builtin_amdgcn_rsqf(ss * (1.f / HD) + epsv);
  u32x4 o;
#pragma unroll
  for (int e = 0; e < 4; ++e) o[e] = cvtpk(f[2 * e] * rs, f[2 * e + 1] * rs);
  return o;
}
__device__ __forceinline__ float u64f(u64 v) { return (float)(unsigned)(v >> 32) * 4294967296.f + (float)(unsigned)v; }
__device__ __forceinline__ u32x4 vscale(u32x4 w, float sc) {
  u32x4 o;
#pragma unroll
  for (int e = 0; e < 4; ++e) o[e] = cvtpk(bflo(w[e]) * sc, bfhi(w[e]) * sc);
  return o;
}

struct PolNA {
  static constexpr bool HAS_BIAS = true, HAS_LSE = false, KV_RS = false, KV_PRE = true, Q_PRE = true, Q_PARTS2 = false, MASK_IN_TABLE = false; static constexpr int LDQ = NQKV, LDK = NQKV, LDO = DM, NUNITS = 1024, TB_LO = 0, TB_HI = 465;
  const bf16* Q; const bf16* K; const bf16* V; bf16* O; float* lse; const u64* ss; const float* qn; const float* kn; const float* rpb;
  int h, sb, r0, rows, kr0, T;
  __device__ __forceinline__ static int rs_of(int r, int rows) { int x = r - 4; return x < 0 ? 0 : (x > rows - 8 ? rows - 8 : x); }
  __device__ __forceinline__ void decode(int u) { h = u & 15; const int blk = u >> 4;
    if (blk < 32) { sb = 0; rows = 128; r0 = 4 * blk; } else { sb = S_P + ((blk - 32) >> 3) * S_S; rows = 32; r0 = 4 * ((blk - 32) & 7); }
    kr0 = rs_of(r0, rows); T = rs_of(r0 + 3, rows) + 8 - kr0; }
  __device__ __forceinline__ int qbase(int p) const { return sb + (r0 + p) * 64; }
  __device__ __forceinline__ int kbase(int t) const { return sb + (kr0 + t) * 64; }
  __device__ __forceinline__ int stride() const { return 1; }
  __device__ __forceinline__ bool first_group() const { return true; }
  __device__ __forceinline__ size_t q2off() const { return 0; }
  __device__ __forceinline__ bool active(int p, int t) const { const int rel = kr0 + t - rs_of(r0 + p, rows); return rel >= 0 && rel <= 7; }
  __device__ __forceinline__ void bias_params(int p, int t, int i, int& tboff, int& lo, int& hi_) const { tboff = (kr0 + t - (r0 + p) + 7) * 31 + 15; int cs = i - 8; cs = cs < 0 ? 0 : (cs > 48 ? 48 : cs); lo = cs - i; hi_ = lo + 15; }
  __device__ __forceinline__ int tb_pre(int x) const { return x < 465 ? x : 464; }
  __device__ __forceinline__ float tb_req(int i) const { return rpb[h * 465 + i]; }
  __device__ __forceinline__ float tb_fin(int, float v) const { return v * LOG2E; }
};
struct PolDil {
  static constexpr bool HAS_BIAS = true, HAS_LSE = true, KV_RS = false, KV_PRE = true, Q_PRE = true, Q_PARTS2 = false, MASK_IN_TABLE = true; static constexpr int LDQ = NQKV, LDK = NQKV, LDO = DM, NUNITS = 1024, TB_LO = -64, TB_HI = 192;
  const bf16* Q; const bf16* K; const bf16* V; bf16* O; float* lse; const u64* ss; const float* qn; const float* kn; const float* t5; int g, dil;
  int h, sb, rho, nb0, kbfirst, T; bool caseB;
  __device__ __forceinline__ void decode(int u) { h = u & 15; const int chunk = u >> 4; int len, c;
    if (chunk < 32) { sb = 0; len = S_P; c = chunk; } else { sb = S_P + ((chunk - 32) >> 3) * S_S; len = S_S; c = (chunk - 32) & 7; }
    const int nblk = (len / dil) >> 6;
    if (nblk >= 4) { caseB = false; const int per = nblk >> 2; rho = c / per; nb0 = 4 * (c - rho * per); kbfirst = nb0 > 0 ? nb0 - 1 : 0; const int kblast = (nb0 + 4 < nblk) ? nb0 + 4 : nblk - 1; T = kblast - kbfirst + 1; }
    else { caseB = true; rho = 2 * c; nb0 = 0; kbfirst = 0; T = 4; } }
  __device__ __forceinline__ int qbase(int p) const { return caseB ? sb + (p & 1) * 64 * dil + rho + (p >> 1) : sb + (nb0 + p) * 64 * dil + rho; }
  __device__ __forceinline__ int kbase(int t) const { return caseB ? sb + (t & 1) * 64 * dil + rho + (t >> 1) : sb + (kbfirst + t) * 64 * dil + rho; }
  __device__ __forceinline__ int stride() const { return dil; }
  __device__ __forceinline__ bool first_group() const { return g == 0; }
  __device__ __forceinline__ size_t q2off() const { return 0; }
  __device__ __forceinline__ int delta(int p, int t) const { return caseB ? ((t >> 1) - (p >> 1)) * 1024 + (t & 1) - (p & 1) : kbfirst + t - (nb0 + p); }
  __device__ __forceinline__ bool active(int p, int t) const { const int d = delta(p, t); return d >= -1 && d <= 1; }
  __device__ __forceinline__ void bias_params(int p, int t, int i, int& tboff, int& lo, int& hi_) const { const int d = delta(p, t); tboff = 64 + 64 * d; lo = -64 - 64 * d; hi_ = 64 - 64 * d; }
  __device__ __forceinline__ int tb_pre(int x) const { return (int)T5B[g][(x >= 0 && x <= 128) ? x : 0] * 48 + g * 16; }
  __device__ __forceinline__ float tb_req(int i) const { return t5[i + h]; }
  __device__ __forceinline__ float tb_fin(int x, float v) const { return (x >= 0 && x <= 128) ? v * LOG2E : NEGM; }
};
struct PolX {
  static constexpr bool HAS_BIAS = false, HAS_LSE = false, KV_RS = false, KV_PRE = false, Q_PRE = false, Q_PARTS2 = true, MASK_IN_TABLE = false; static constexpr int LDQ = 512, LDK = 1024, LDO = 512, NUNITS = 256, TB_LO = 0, TB_HI = 0;
  const bf16* Q; const bf16* K; const bf16* V; bf16* O; float* lse; const u64* ss; const float* qn; const float* kn;
  int h, q0, mb, T;
  __device__ __forceinline__ void decode(int u) { h = u & 3; q0 = (u >> 2) * 256; mb = q0 < S_P ? 0 : 1 + ((q0 - S_P) >> 11); T = 4; }
  __device__ __forceinline__ int qbase(int p) const { return q0 + p * 64; }
  __device__ __forceinline__ int kbase(int t) const { return mb * NMEM + t * 64; }
  __device__ __forceinline__ int stride() const { return 1; }
  __device__ __forceinline__ bool first_group() const { return true; }
  __device__ __forceinline__ size_t q2off() const { return (size_t)(WS_XQ2 - WS_XQ) / 2; }
  __device__ __forceinline__ bool active(int, int) const { return true; }
  __device__ __forceinline__ void bias_params(int, int, int, int& tboff, int& lo, int& hi_) const { tboff = 0; lo = 0; hi_ = 0; }
  __device__ __forceinline__ int tb_pre(int) const { return 0; }
  __device__ __forceinline__ float tb_req(int) const { return 0.f; }
  __device__ __forceinline__ float tb_fin(int, float) const { return 0.f; }
};

template <class P> __device__ __forceinline__ void attn_phase(P pol, LAS unsigned char* L, int G) {
  int tid_l = threadIdx.x; asm volatile("" : "+v"(tid_l));
  const int tid = tid_l, lane = tid & 63, r32 = lane & 31, hi = lane >> 5; const int wid = __builtin_amdgcn_readfirstlane(tid >> 6);
  const int pr = wid >> 1, qi = 32 * (wid & 1) + r32;
  LAS unsigned char* const Vl = L + A_V; LAS unsigned char* const Kl = L + A_K;
  LAS float* const wsf = (LAS float*)(L + A_WS) + wid * 64; LAS float* const gq = (LAS float*)(L + A_GQ); LAS float* const tb = (LAS float*)(L + A_TB0);
  LAS unsigned char* const ost = L + A_OST + wid * 8192;
  const int sr = tid >> 4, sc = (tid & 15) * 8, vst0 = v_st(sr, sc), vst1 = vst0 + 8192, kst0 = KSWZ(sr, sc * 2), kst1 = kst0 + 8192;
  const int vb0 = (int)(unsigned)(uintptr_t)Vl + v_rd_base(lane);
  if (!P::Q_PRE && tid < HD) gq[tid] = pol.qn[tid] * pol.kn[tid] * (ATTN_SCALE * LOG2E);
  __syncthreads();
  static_assert(P::TB_HI - P::TB_LO <= NWAVES * 64, "one bias table entry per thread");
  const int tbi = P::HAS_BIAS ? pol.tb_pre(P::TB_LO + tid) : 0; (void)tbi;
  for (int u = blockIdx.x; u < P::NUNITS; u += G) {
    pol.decode(u);
    const int T = pol.T, hoff = pol.h * HD;
    const int qb = __builtin_amdgcn_readfirstlane(pol.qbase(pr)), strd = pol.stride();
    u32x4 ks0, ks1, vs0, vs1; u64 rs0 = 0, rs1 = 0;
    const unsigned so0 = (unsigned)(sr * strd * P::LDK + hoff + sc), so1 = so0 + (unsigned)(32 * strd * P::LDK);
#define SLOAD(t) do { const size_t tb_ = (size_t)__builtin_amdgcn_readfirstlane(pol.kbase(t)) * P::LDK; const bf16* Kt_ = pol.K + tb_; const bf16* Vt_ = pol.V + tb_; \
      ks0 = *(const GAS u32x4*)(Kt_ + so0); ks1 = *(const GAS u32x4*)(Kt_ + so1); vs0 = *(const GAS u32x4*)(Vt_ + so0); vs1 = *(const GAS u32x4*)(Vt_ + so1); \
      if (P::KV_RS) { const u64* sp_ = pol.ss + __builtin_amdgcn_readfirstlane(pol.kbase(t)); rs0 = sp_[sr * strd]; rs1 = sp_[(32 + sr) * strd]; } } while (0)
#define SWRITE(b) do { float e0_ = RMS_EPS, e1_ = RMS_EPS; \
      if (P::KV_RS) { const float v0_ = u64f(rs0) * SS_INV + RMS_EPS, v1_ = u64f(rs1) * SS_INV + RMS_EPS; e0_ = RMS_EPS * v0_; e1_ = RMS_EPS * v1_; \
        vs0 = vscale(vs0, __builtin_amdgcn_rsqf(v0_)); vs1 = vscale(vs1, __builtin_amdgcn_rsqf(v1_)); } \
      *(LAS u32x4*)(Vl + (b) * SHM_V + vst0) = vs0; *(LAS u32x4*)(Vl + (b) * SHM_V + vst1) = vs1; \
      *(LAS u32x4*)(Kl + (b) * SHM_K + kst0) = P::KV_PRE ? ks0 : knorm(ks0, e0_); *(LAS u32x4*)(Kl + (b) * SHM_K + kst1) = P::KV_PRE ? ks1 : knorm(ks1, e1_); } while (0)
    SLOAD(0);
    const float tbv = P::HAS_BIAS ? pol.tb_req(tbi) : 0.f;
    bf16x8 qf[8];
    if (P::Q_PRE) {
      const bf16* Qp = pol.Q + (size_t)qb * P::LDQ + (unsigned)(qi * strd * P::LDQ + hoff + hi * 8);
#pragma unroll
      for (int d0 = 0; d0 < 8; ++d0) qf[d0] = __builtin_bit_cast(bf16x8, *(const GAS u32x4*)(Qp + d0 * 16));
    } else { const bf16* Qp = pol.Q + (size_t)qb * P::LDQ + (unsigned)(qi * strd * P::LDQ + hoff + hi * 8);
      const u64 ssq = pol.ss[qb + qi * strd];
      u32x4 qw[8]; float ss = 0.f;
#pragma unroll
      for (int d0 = 0; d0 < 8; ++d0) qw[d0] = *(const GAS u32x4*)(Qp + d0 * 16);
      if (P::Q_PARTS2) {
#pragma unroll
        for (int d0 = 0; d0 < 8; ++d0) { const u32x4 q2 = *(const GAS u32x4*)(Qp + pol.q2off() + d0 * 16);
#pragma unroll
          for (int e = 0; e < 4; ++e) qw[d0][e] = cvtpk(bflo(qw[d0][e]) + bflo(q2[e]), bfhi(qw[d0][e]) + bfhi(q2[e])); } }
      const float varq = u64f(ssq) * SS_INV + RMS_EPS;
#pragma unroll
      for (int d0 = 0; d0 < 8; ++d0)
#pragma unroll
        for (int e = 0; e < 4; ++e) { const float a = bflo(qw[d0][e]), b = bfhi(qw[d0][e]); ss += a * a + b * b; }
      ss = pl32_sum(ss);
      const float rq = __builtin_amdgcn_rsqf(ss * (1.f / HD) + RMS_EPS * varq);
#pragma unroll
      for (int d0 = 0; d0 < 8; ++d0) { const f32x4 g0 = *(const LAS f32x4*)(gq + d0 * 16 + hi * 8), g1 = *(const LAS f32x4*)(gq + d0 * 16 + hi * 8 + 4); u32x4 w;
        w[0] = cvtpk(bflo(qw[d0][0]) * rq * g0[0], bfhi(qw[d0][0]) * rq * g0[1]); w[1] = cvtpk(bflo(qw[d0][1]) * rq * g0[2], bfhi(qw[d0][1]) * rq * g0[3]);
        w[2] = cvtpk(bflo(qw[d0][2]) * rq * g1[0], bfhi(qw[d0][2]) * rq * g1[1]); w[3] = cvtpk(bflo(qw[d0][3]) * rq * g1[2], bfhi(qw[d0][3]) * rq * g1[3]);
        qf[d0] = __builtin_bit_cast(bf16x8, w); } }
    if (P::HAS_BIAS) { const int x = P::TB_LO + tid; if (x < P::TB_HI) tb[x] = pol.tb_fin(x, tbv); }
    SWRITE(0);
    __syncthreads();
    constexpr float m_reg = 0.f; float l_reg = 0.f; f32x16 o[4] = {};
#define PK4(Pv, BASE, OUT) do { unsigned a0 = cvtpk(Pv[BASE + 0], Pv[BASE + 1]), a1 = cvtpk(Pv[BASE + 2], Pv[BASE + 3]);   \
    unsigned b0_ = cvtpk(Pv[BASE + 4], Pv[BASE + 5]), b1_ = cvtpk(Pv[BASE + 6], Pv[BASE + 7]);                              \
    auto r0_ = __builtin_amdgcn_permlane32_swap(a0, b0_, false, false); auto r1_ = __builtin_amdgcn_permlane32_swap(a1, b1_, false, false); \
    u32x4 w_ = {r0_[0], r1_[0], r0_[1], r1_[1]}; OUT = __builtin_bit_cast(bf16x8, w_); } while (0)
#define PIN8(a) asm volatile("" : "+v"(a[0]), "+v"(a[1]), "+v"(a[2]), "+v"(a[3]), "+v"(a[4]), "+v"(a[5]), "+v"(a[6]), "+v"(a[7]))
    for (int t = 0; t < T; ++t) {
      const int b = t & 1;
      if (t + 1 < T) SLOAD(t + 1);
      if (pol.active(pr, t)) {
        f32x16 p0 = {}, p1 = {};
        int tboff = 0, lo = 0, hi_ = 0; if (P::HAS_BIAS) pol.bias_params(pr, t, qi, tboff, lo, hi_);
        if (P::HAS_BIAS) {
          const LAS unsigned char* tbp = (const LAS unsigned char*)tb + 4 * (tboff + 4 * hi - qi);
#pragma unroll
          for (int rr = 0; rr < 16; ++rr) { const int cj = (rr & 3) + 8 * (rr >> 2); p0[rr] = *(const LAS float*)(tbp + 4 * cj); p1[rr] = *(const LAS float*)(tbp + 4 * (cj + 32)); }
        }
        qkt(p0, p1, Kl + b * SHM_K, qf, r32, hi);
        if (P::HAS_BIAS && !P::MASK_IN_TABLE) {
          const int dbase = 4 * hi - qi - lo; const unsigned width = (unsigned)(hi_ - lo);
#pragma unroll
          for (int rr = 0; rr < 16; ++rr) { const int cj = (rr & 3) + 8 * (rr >> 2);
            p0[rr] = ((unsigned)(dbase + cj) <= width) ? p0[rr] : NEGM; p1[rr] = ((unsigned)(dbase + cj + 32) <= width) ? p1[rr] : NEGM; }
        }
        float ps = 0.f;
#pragma unroll
        for (int r = 0; r < 16; ++r) { p0[r] = __builtin_amdgcn_exp2f(p0[r]); p1[r] = __builtin_amdgcn_exp2f(p1[r]); ps += p0[r] + p1[r]; }
        ps = pl32_sum(ps);
        l_reg += ps;
        bf16x8 pa0, pa1, pa2, pa3;
        PK4(p0, 0, pa0); PK4(p0, 8, pa1); PK4(p1, 0, pa2); PK4(p1, 8, pa3);
        SBAR();
        const int vb = vb0 + b * SHM_V;
        pv_one<0>(o[0], vb, pa0, pa1, pa2, pa3); pv_one<1>(o[1], vb, pa0, pa1, pa2, pa3); pv_one<2>(o[2], vb, pa0, pa1, pa2, pa3); pv_one<3>(o[3], vb, pa0, pa1, pa2, pa3);
      }
      if (t + 1 < T) SWRITE(b ^ 1);
      __syncthreads();
    }
#undef PK4
#undef PIN8
    if (hi == 0) wsf[32 + r32] = l_reg;
    asm volatile("s_waitcnt lgkmcnt(0)" ::: "memory");
#pragma unroll
    for (int r = 0; r < 16; ++r) { const int orow = crow(r, hi); const float rl = __builtin_amdgcn_rcpf(wsf[32 + orow]);
#pragma unroll
      for (int d0 = 0; d0 < 4; ++d0) *(LAS unsigned short*)(ost + (orow * 128 + d0 * 32 + r32) * 2) = (unsigned short)f2bf(o[d0][r] * rl); }
    asm volatile("s_waitcnt lgkmcnt(0)" ::: "memory");
    if (P::HAS_LSE) {
      const bool first = pol.first_group();
      float lse_n = (m_reg + __builtin_amdgcn_logf(l_reg)) * 0.6931471805599453f;
      if (!first) { if (hi == 0) { float* lp = pol.lse + (size_t)(qb + qi * strd) * 16 + pol.h; const float lse_p = *lp; const float Lm = fmaxf(lse_p, lse_n);
          const float wp = __expf(lse_p - Lm), wn = __expf(lse_n - Lm), sm = wp + wn, inv = 1.0f / sm; wsf[r32] = wp * inv; wsf[32 + r32] = wn * inv; *lp = Lm + __logf(sm); }
        asm volatile("s_waitcnt lgkmcnt(0)" ::: "memory"); }
      else { if (hi == 0) pol.lse[(size_t)(qb + qi * strd) * 16 + pol.h] = lse_n; }
#pragma unroll
      for (int it = 0; it < 8; ++it) { const int row = it * 4 + (lane >> 4), ch = lane & 15;
        u32x4 v = *(const LAS u32x4*)(ost + row * 256 + ch * 16);
        bf16* gp = pol.O + (size_t)qb * P::LDO + (unsigned)((32 * (wid & 1) + row) * strd * P::LDO + hoff + ch * 8);
        if (!first) { const u32x4 pv_ = *(const GAS u32x4*)gp; const float wp = wsf[row], wn = wsf[32 + row];
#pragma unroll
          for (int e = 0; e < 4; ++e) v[e] = cvtpk(bflo(pv_[e]) * wp + bflo(v[e]) * wn, bfhi(pv_[e]) * wp + bfhi(v[e]) * wn); }
        *(GAS u32x4*)gp = v; }
    } else {
#pragma unroll
      for (int it = 0; it < 8; ++it) { const int row = it * 4 + (lane >> 4), ch = lane & 15;
        const u32x4 v = *(const LAS u32x4*)(ost + row * 256 + ch * 16);
        *(GAS u32x4*)(pol.O + (size_t)qb * P::LDO + (unsigned)((32 * (wid & 1) + row) * strd * P::LDO + hoff + ch * 8)) = v; }
    }
    asm volatile("s_waitcnt lgkmcnt(0)" ::: "memory");
#undef SLOAD
#undef SWRITE
  }
  __syncthreads();
}
#undef KSWZ
#undef SBAR
}

#ifndef NAIVE_NA
#define NAIVE_NA 0
#endif
#ifndef NAIVE_DIL
#define NAIVE_DIL 0
#endif
#ifndef NAIVE_X
#define NAIVE_X 0
#endif
#ifndef R_PRO
#define R_PRO 1
#endif
#ifndef R_THIN
#define R_THIN 1
#endif
#ifndef R_ATT_NA
#define R_ATT_NA 1
#endif
#ifndef R_ATT_DIL
#define R_ATT_DIL 1
#endif
#ifndef R_ATT_X
#define R_ATT_X 1
#endif
#ifndef R_GQ
#define R_GQ 1
#endif
#ifndef R_GR
#define R_GR 1
#endif
#ifndef R_GU
#define R_GU 1
#endif
#ifndef WGM_QKV
#define WGM_QKV 4
#endif
#ifndef WGM_UP
#define WGM_UP 4
#endif
#ifndef WGM_RES
#define WGM_RES 4
#endif
#ifndef MK_PER_PHASE
#define MK_PER_PHASE 0
#endif
constexpr int NPHASES = 1 + 2 * 8 + 2 * 10;
struct KvOrder {
    int G, c;
    __device__ __forceinline__ bool next(int i, pg8::Unit& u) const { const int L = i * G + c; if (L >= 80) return false; const int l = L / 20, r = L - l * 20; u.pm = l * 5 + (r % 5); u.pn = l * 4 + (r / 5); u.ko = 0; return true; }
    __device__ __forceinline__ void a_ready(const pg8::Unit&) const {}
    __device__ __forceinline__ void done(const pg8::Unit&) const {}
};
struct QxOrder {
    int G, c;
    __device__ __forceinline__ bool next(int i, pg8::Unit& u) const { const int L = i * G + c; if (c < 0 || L >= 256) return false; u.pm = L >> 2; u.pn = (L >> 1) & 1; u.ko = (L & 1) * (DM / 2); return true; }
    __device__ __forceinline__ void a_ready(const pg8::Unit&) const {}
    __device__ __forceinline__ void done(const pg8::Unit&) const {}
};
struct Args { const float* in[25]; float* out; unsigned char* ws; int ph_lo, ph_hi; };
typedef const __attribute__((address_space(4))) Args* kargp;
__global__ void __launch_bounds__(NWAVES * 64, 2) fwd(Args args) {
    extern __shared__ __attribute__((aligned(16))) unsigned char lds[];
    LAS unsigned char* const L = (LAS unsigned char*)lds;
    const int G = gridDim.x;
    { const int t0 = threadIdx.x; for (int u = t0; u < (LDS_BYTES - LDSCTL_OFF) / 4; u += NWAVES * 64) ((LAS unsigned*)(L + LDSCTL_OFF))[u] = 0u; }
    __syncthreads();
    XcdBarrier bar = xcd_barrier_post((unsigned*)(args.ws + WS_CTL) + CW_BAR, (volatile LAS unsigned*)(L + MISC_OFF) + 8);
    const int lo = args.ph_lo, hi = args.ph_hi; int ph = 0;
#define PH_BEGIN if (ph >= lo && ph < hi) { kargp ka = (kargp)__builtin_amdgcn_kernarg_segment_ptr(); asm volatile("" : "+s"(ka)); int tid = threadIdx.x; asm volatile("" : "+v"(tid)); \
        const int lane = tid & 63, wave = __builtin_amdgcn_readfirstlane(tid >> 6), gw = blockIdx.x * NWAVES + wave, NGW = G * NWAVES; (void)lane; (void)gw; (void)NGW; unsigned char* const ws = ka->ws; (void)ws;
#define PH_END   if (ph + 1 < hi) xcd_barrier(bar); } ++ph;
#define WSB(off) ((bf16*)(ws + (off)))

    PH_BEGIN
        LAS float* scr = (LAS float*)(L + RING_OFF + wave * 16384);
        for (int rep_ = 0; rep_ < R_PRO; ++rep_) {
        transpose_tensor(ka->in[8], ka->in[4], 2 * DM, 2, DM, NQKV, WSB(WS_WQKVA), scr, gw, NGW, lane);
        transpose_tensor(ka->in[13], ka->in[4] + DM, 2 * DM, 2, DM, 3 * NQKV, WSB(WS_WQKVB), scr, gw, NGW, lane);
        transpose_tensor(ka->in[12], nullptr, 0, 2, DM, DM, WSB(WS_WOA), scr, gw, NGW, lane);
        transpose_tensor(ka->in[17], nullptr, 0, 2, DM, DM, WSB(WS_WOB), scr, gw, NGW, lane);
        transpose_tensor(ka->in[18], ka->in[5], DM, 4, DM, XHEAD * HD, WSB(WS_WQX), scr, gw, NGW, lane);
        transpose_tensor(ka->in[19], nullptr, 0, 4, DM, 2 * XHEAD * HD, WSB(WS_WKVX), scr, gw, NGW, lane);
        transpose_tensor(ka->in[22], nullptr, 0, 4, XHEAD * HD, DM, WSB(WS_WOX), scr, gw, NGW, lane);
        transpose_tensor(ka->in[23], ka->in[7], DM, 4, DM, DFF, WSB(WS_WUP), scr, gw, NGW, lane);
        transpose_tensor(ka->in[24], nullptr, 0, 4, DFF, DM, WSB(WS_WDN), scr, gw, NGW, lane);
        const float* mem_prompt = ka->in[2]; const float* mem_sample = ka->in[3]; const float* g_mem = ka->in[6]; bf16* MEMN = WSB(WS_OG);
        for (int t = gw; t < 4 * MEMROWS; t += NGW) { const int i = t / MEMROWS, r = t - i * MEMROWS;
            const float* mr = r < NMEM ? mem_prompt + (size_t)r * DM : mem_sample + (size_t)(r - NMEM) * DM;
            rms_row_to_bf16(mr, g_mem + i * DM, MEMN + (size_t)t * DM, lane); }
        { const float* x0 = ka->in[0]; const float* x1 = ka->in[1]; bf16* XB = WSB(WS_H); u64* SS = (u64*)(ws + WS_SS);
          for (int m = gw; m < MTOK; m += NGW) row_to_bf16_ss(m < S_P ? x0 + (size_t)m * DM : x1 + (size_t)(m - S_P) * DM, XB + (size_t)m * DM, SS + m, lane);
          for (int i = blockIdx.x * (NWAVES * 64) + tid; i < 2 * MTOK; i += G * NWAVES * 64) SS[MTOK + i] = 0ull; }
        }
        __syncthreads();
    PH_END
    for (int layer = 0; layer < 4; ++layer) {
        const int li = layer >> 1; const bool odd = (layer & 1) != 0;
        const int ngroups = odd ? 3 : 1;
        for (int step = 0; step <= ngroups; ++step) {
            PH_BEGIN
                if (step > 0) {
                    const int grp = step - 1; bf16* QKV = WSB((grp & 1) ? WS_OG : WS_QKV);
                    if (!odd) {
                        at::PolNA P{}; P.Q = QKV; P.K = QKV + DM; P.V = QKV + 2 * DM; P.O = WSB(WS_O); P.lse = nullptr; P.ss = (const u64*)(ws + WS_SS); P.qn = ka->in[9] + li * HD; P.kn = ka->in[10] + li * HD; P.rpb = ka->in[11] + (size_t)li * 16 * 15 * 31;
                        for (int rep_ = 0; rep_ < R_ATT_NA; ++rep_) at::attn_phase<at::PolNA>(P, L, G);
                    } else { const int dil = grp == 0 ? 1 : (grp == 1 ? 4 : 16);
                        at::PolDil P{}; P.Q = QKV; P.K = QKV + DM; P.V = QKV + 2 * DM; P.O = WSB(WS_O); P.lse = (float*)(ws + WS_LSE);
                        P.ss = (const u64*)(ws + WS_SS); P.qn = ka->in[14] + (li * 3 + grp) * HD; P.kn = ka->in[15] + (li * 3 + grp) * HD; P.t5 = ka->in[16]; P.g = grp; P.dil = dil;
                        for (int rep_ = 0; rep_ < R_ATT_DIL; ++rep_) at::attn_phase<at::PolDil>(P, L, G);
                    }
                }
                if (step < ngroups) {
                    const int grp = step;
                    if (layer > 0 && grp == 0) { u64* SS = (u64*)(ws + WS_SS); for (int i = blockIdx.x * (NWAVES * 64) + tid; i < MTOK; i += G * NWAVES * 64) SS[2 * MTOK + i] = 0ull; }
                    const bf16* Bt = odd ? WSB(WS_WQKVB) + ((size_t)li * 3 + grp) * NQKV * DM : WSB(WS_WQKVA) + (size_t)li * NQKV * DM;
                    pg8::Gemm g{WSB(WS_H), Bt, MTOK, NQKV, DM}; pg8::StaticOrder S; S.init(MTOK, NQKV, G, (int)blockIdx.x, WGM_QKV);
                    LAS float* varl = (LAS float*)(L + LDSCTL_OFF + 1024); LAS float* red = (LAS float*)(L + LDSCTL_OFF + 4096); LAS float* gql = (LAS float*)(L + LDSCTL_OFF + 3072);
                    pg8::Unit u0, u3; const int pm0 = S.next(0, u0) ? u0.pm : -1, pm1 = S.next(3, u3) ? u3.pm : -1;
                    __syncthreads();
                    { const int pmx = tid < 256 ? pm0 : pm1; if (pmx >= 0) varl[tid] = at::u64f(((const u64*)(ws + WS_SS))[pmx * 256 + (tid & 255)]) * SS_INV + RMS_EPS; }
                    if (tid < HD) { const float* qn_ = odd ? ka->in[14] + (li * 3 + grp) * HD : ka->in[9] + li * HD; const float* kn_ = odd ? ka->in[15] + (li * 3 + grp) * HD : ka->in[10] + li * HD;
                        gql[tid] = qn_[tid] * kn_[tid] * (ATTN_SCALE * LOG2E); }
                    __syncthreads();
                    pg8::EpiQKV E{WSB((grp & 1) ? WS_OG : WS_QKV), NQKV, varl, red, pm0, pm1, (const u64*)(ws + WS_SS), gql};
                    for (int rep_ = 0; rep_ < R_GQ; ++rep_) pg8::gemm_phase<pg8::EpiQKV, pg8::StaticOrder, true, true>(L + RING_OFF, g, S, E);
                }
            PH_END
        }
        PH_BEGIN
            float* X = ka->out;
            pg8::Gemm g{WSB(WS_O), (odd ? WSB(WS_WOB) : WSB(WS_WOA)) + (size_t)li * DM * DM, MTOK, DM, DM}; pg8::StaticOrder S; S.init(MTOK, DM, G, (int)blockIdx.x, WGM_RES);
            u64* SS = (u64*)(ws + WS_SS);
            for (int i = blockIdx.x * (NWAVES * 64) + tid; i < MTOK; i += G * NWAVES * 64) SS[i] = 0ull;
            pg8::EpiRes E{WSB(WS_H), nullptr, DM, SS + MTOK, nullptr};
            for (int rep_ = 1; rep_ < R_GR; ++rep_) { pg8::EpiRes E2 = E; E2.outf = (float*)(ws + 960 * MiB); E2.ssout = (u64*)(ws + 8 * MiB); pg8::gemm_phase<pg8::EpiRes, pg8::StaticOrder, true, true>(L + RING_OFF, g, S, E2); }
            pg8::gemm_phase<pg8::EpiRes, pg8::StaticOrder, true, true>(L + RING_OFF, g, S, E);
        PH_END
        PH_BEGIN
            const int nkv = (layer == 0 && G > 160) ? 80 : 0;
            pg8::Gemm g{WSB(WS_H), WSB(WS_WQX) + (size_t)layer * 512 * DM, MTOK, 512, DM / 2, DM}; QxOrder S{G - nkv, (int)blockIdx.x - nkv};
            pg8::EpiBf16<0> E{WSB(WS_XQ), 512, 0, 0, (size_t)(WS_XQ2 - WS_XQ) / 2};
            for (int rep_ = 0; rep_ < R_GU; ++rep_) pg8::gemm_phase<pg8::EpiBf16<0>, QxOrder, true, true>(L + RING_OFF, g, S, E);
            if (layer == 0) {
                pg8::Gemm g2{WSB(WS_OG), WSB(WS_WKVX), 4 * MEMROWS, 4 * 1024, DM}; KvOrder S2{G, (int)blockIdx.x};
                pg8::EpiBf16<0> E2{WSB(WS_KVM), 1024, 1024, 0};
                pg8::gemm_phase<pg8::EpiBf16<0>, KvOrder, true, true>(L + RING_OFF, g2, S2, E2);
            }
        PH_END
        PH_BEGIN
            const bf16* kv = WSB(WS_KVM) + (size_t)layer * MEMROWS * 1024;
#if NAIVE_X
            NaiveX P{WSB(WS_XQ), kv, kv + 512, 1024, ka->in[20] + layer * HD, ka->in[21] + layer * HD, WSB(WS_XO), 512, nullptr, 512};
            attn_naive<NaiveX, 512>(P, gw, NGW, lane);
#else
            at::PolX P{}; P.Q = WSB(WS_XQ); P.K = kv; P.V = kv + 512; P.O = WSB(WS_XO); P.lse = nullptr; P.ss = (const u64*)(ws + WS_SS) + MTOK; P.qn = ka->in[20] + layer * HD; P.kn = ka->in[21] + layer * HD;
            for (int rep_ = 0; rep_ < R_ATT_X; ++rep_) at::attn_phase<at::PolX>(P, L, G);
#endif
        PH_END
        PH_BEGIN
            float* X = ka->out;
            pg8::Gemm g{WSB(WS_XO), WSB(WS_WOX) + (size_t)layer * DM * 512, MTOK, DM, 512}; pg8::StaticOrder S; S.init(MTOK, DM, G, (int)blockIdx.x, WGM_RES);
            u64* SS = (u64*)(ws + WS_SS); pg8::EpiRes E{WSB(WS_H), nullptr, DM, SS + 2 * MTOK, nullptr};
            for (int rep_ = 1; rep_ < R_GR; ++rep_) { pg8::EpiRes E2 = E; E2.outf = (float*)(ws + 960 * MiB); E2.ssout = (u64*)(ws + 8 * MiB); pg8::gemm_phase<pg8::EpiRes, pg8::StaticOrder, true, true>(L + RING_OFF, g, S, E2); }
            pg8::gemm_phase<pg8::EpiRes, pg8::StaticOrder, true, true>(L + RING_OFF, g, S, E);
        PH_END
        PH_BEGIN
            { u64* SS = (u64*)(ws + WS_SS); for (int i = blockIdx.x * (NWAVES * 64) + tid; i < MTOK; i += G * NWAVES * 64) SS[MTOK + i] = 0ull; }
            pg8::Gemm g{WSB(WS_H), WSB(WS_WUP) + (size_t)layer * DFF * DM, MTOK, DFF, DM}; pg8::StaticOrder S; S.init(MTOK, DFF, G, (int)blockIdx.x, WGM_UP);
            pg8::EpiBf16<2> E{WSB(WS_HID), DFF, 0, 0};
            for (int rep_ = 0; rep_ < R_GU; ++rep_) pg8::gemm_phase<pg8::EpiBf16<2>, pg8::StaticOrder, true, true>(L + RING_OFF, g, S, E);
        PH_END
        PH_BEGIN
            float* X = ka->out;
            pg8::Gemm g{WSB(WS_HID), WSB(WS_WDN) + (size_t)layer * DM * DFF, MTOK, DM, DFF}; pg8::StaticOrder S; S.init(MTOK, DM, G, (int)blockIdx.x, WGM_RES);
            u64* SS = (u64*)(ws + WS_SS); pg8::EpiRes E{WSB(WS_H), layer == 3 ? X : nullptr, DM, SS, SS + 2 * MTOK};
            for (int rep_ = 1; rep_ < R_GR; ++rep_) { pg8::EpiRes E2 = E; E2.outf = (float*)(ws + 960 * MiB); E2.ssout = (u64*)(ws + 8 * MiB); pg8::gemm_phase<pg8::EpiRes, pg8::StaticOrder, true, true>(L + RING_OFF, g, S, E2); }
            pg8::gemm_phase<pg8::EpiRes, pg8::StaticOrder, true, true>(L + RING_OFF, g, S, E);
        PH_END
    }
#undef PH_BEGIN
#undef PH_END
#undef WSB
}

extern "C" void kernel_launch(void* const* d_in, const int* in_sizes, int n_in, void* d_out, int out_size, void* d_ws, size_t ws_size, hipStream_t stream) {
    static int grid = 0;
    if (grid == 0) {
        if (n_in != 25 || out_size != MTOK * DM || ws_size < WS_END) { fprintf(stderr, "kernel_launch: unexpected shapes (n_in %d out %d ws %zu need %zu); nothing launched\n", n_in, out_size, ws_size, (size_t)WS_END); grid = -1; return; }
        int dev = 0, cus = 0, per_cu = 0;
        if (hipGetDevice(&dev) != hipSuccess || hipDeviceGetAttribute(&cus, hipDeviceAttributeMultiprocessorCount, dev) != hipSuccess) { grid = -1; return; }
        if (hipFuncSetAttribute((const void*)fwd, hipFuncAttributeMaxDynamicSharedMemorySize, LDS_BYTES) != hipSuccess) { fprintf(stderr, "kernel_launch: hipFuncSetAttribute failed\n"); grid = -1; return; }
        if (hipOccupancyMaxActiveBlocksPerMultiprocessor(&per_cu, (const void*)fwd, NWAVES * 64, LDS_BYTES) != hipSuccess || per_cu < 1) { fprintf(stderr, "kernel_launch: occupancy query says %d blocks per CU\n", per_cu); (void)hipGetLastError(); grid = -1; return; }
        grid = cus;
    }
    if (grid < 0) return;
    (void)hipMemsetAsync((char*)d_ws + WS_CTL, 0, CTL_ZERO_BYTES, stream);
    Args a{};
    for (int i = 0; i < 25; ++i) a.in[i] = (const float*)d_in[i];
    a.out = (float*)d_out; a.ws = (unsigned char*)d_ws;
#if MK_PER_PHASE
    for (int p = 0; p < NPHASES; ++p) { a.ph_lo = p; a.ph_hi = p + 1; hipLaunchKernelGGL(fwd, dim3(grid), dim3(NWAVES * 64), LDS_BYTES, stream, a); }
#else
    a.ph_lo = 0; a.ph_hi = NPHASES;
    hipLaunchKernelGGL(fwd, dim3(grid), dim3(NWAVES * 64), LDS_BYTES, stream, a);
#endif
    const hipError_t le = hipPeekAtLastError();
    if (le != hipSuccess) fprintf(stderr, "kernel_launch: launch failed: %s\n", hipGetErrorName(le));
}
```

```cpp
#include <hip/hip_runtime.h>
#include <cstdio>
#include <cstdint>
namespace pg8 {
#define PG8_LAS __attribute__((address_space(3)))
typedef unsigned short bf16_t;
typedef short bf16x8 __attribute__((ext_vector_type(8)));
typedef float f32x4 __attribute__((ext_vector_type(4)));
typedef unsigned u32x4 __attribute__((ext_vector_type(4)));
constexpr int BM = 256, BK = 64, HALF = 128, HTB = HALF * BK * 2  , STAGE_BYTES = 8 * HTB, NXCD = 8, WGM = 4;

__host__ __device__ __forceinline__ int lds_byte(int r, int c) { const int st = (r >> 4) * 2 + (c >> 5), rr = r & 15, cc = c & 31, ob = rr * 64 + cc * 2; return st * 1024 + (ob ^ (((ob >> 9) & 1) << 5)); }
__host__ __device__ __forceinline__ void stage_rc(int b, int& R, int& C) { const int st = b / 1024, sb = b % 1024, swz = sb ^ (((sb >> 9) & 1) << 5); R = (st >> 1) * 16 + swz / 64; C = (st & 1) * 32 + (swz % 64) / 2; }
__host__ __device__ __forceinline__ int perm32(int rho) { const int n = rho >> 4, i = rho & 15; return 8 * (i >> 2) + 4 * n + (i & 3); }

struct Unit { int pm, pn, ko; };
struct Gemm { const bf16_t* A; const bf16_t* Bt; int M, N, K, ld; };

struct StaticOrder {
    int nM, nN, nwg, G, c, wgm;
    __host__ __device__ void init(int M, int N, int G_, int c_, int wgm_ = WGM) { nM = M / BM; nN = N / BM; nwg = nM * nN; G = G_; c = c_; wgm = wgm_; }
    __host__ __device__ bool next(int i, Unit& u) const {
        const long L = (long)i * G + c; if (L >= nwg) return false;
        int wgid = (int)L; { const int q = nwg / NXCD, r = nwg % NXCD, xcd = wgid % NXCD, off = wgid / NXCD; wgid = (xcd < r ? xcd * (q + 1) : r * (q + 1) + (xcd - r) * q) + off; }
        const int nig = wgm * nN, gid = wgid / nig, fm = gid * wgm, gsz = (nM - fm) < wgm ? (nM - fm) : wgm;
        u.pm = fm + ((wgid % nig) % gsz); u.pn = (wgid % nig) / gsz; u.ko = 0; return true;
    }
    __device__ __forceinline__ void a_ready(const Unit&) const {}
    __device__ __forceinline__ void done(const Unit&) const {}
};

__device__ __forceinline__ unsigned cvt_pk_bf16(float lo, float hi) { unsigned r; asm volatile("v_cvt_pk_bf16_f32 %0, %1, %2" : "=v"(r) : "v"(lo), "v"(hi)); return r; }
typedef float f32x2 __attribute__((ext_vector_type(2)));
typedef unsigned u32x2 __attribute__((ext_vector_type(2)));
template <int ACT> struct EpiBf16 {
    static constexpr bool PERM = true, AFTER_DRAIN = false; static_assert(ACT == 0 || ACT == 2, "EpiBf16: ACT is 0 (none) or 2 (squared relu)");
    bf16_t* O; int ldc; int split_cols; size_t split_stride; size_t ko_stride;
    __device__ __forceinline__ void operator()(const f32x4 (&acc)[2][2][4][2], const Unit& u, int wr, int wc, int fr, int fq) const {
        const int row0 = u.pm * BM + wr * 64 + fr; int colt = u.pn * BM; bf16_t* base = O;
        if (split_cols) { const int t = colt / split_cols; base += (size_t)t * split_stride; colt -= t * split_cols; }
        if (u.ko) base += ko_stride;
        const int col0 = colt + wc * 32 + 8 * fq;
#pragma unroll
        for (int ai = 0; ai < 2; ++ai)
#pragma unroll
            for (int m = 0; m < 4; ++m) { bf16_t* rowp = base + (size_t)(row0 + ai * HALF + m * 16) * ldc + col0;
#pragma unroll
                for (int bj = 0; bj < 2; ++bj) { f32x4 v0 = acc[ai][bj][m][0], v1 = acc[ai][bj][m][1];
                    if (ACT == 2) {
#pragma unroll
                        for (int e = 0; e < 4; ++e) { const float a = fmaxf(v0[e], 0.f), b = fmaxf(v1[e], 0.f); v0[e] = a * a; v1[e] = b * b; } }
                    u32x4 w; w.x = cvt_pk_bf16(v0[0], v0[1]); w.y = cvt_pk_bf16(v0[2], v0[3]); w.z = cvt_pk_bf16(v1[0], v1[1]); w.w = cvt_pk_bf16(v1[2], v1[3]);
                    *(u32x4*)(rowp + bj * HALF) = w; } }
    }
};
struct EpiRes {
    static constexpr bool PERM = true, AFTER_DRAIN = false;
    bf16_t* xb; float* outf; int ldc; unsigned long long* ssout; const unsigned long long* ssin;
    __device__ __forceinline__ void operator()(const f32x4 (&acc)[2][2][4][2], const Unit& u, int wr, int wc, int fr, int fq) const {
        const int row0 = u.pm * BM + wr * 64 + fr, col0 = u.pn * BM + wc * 32 + 8 * fq;
        float sq[2][4];
#pragma unroll
        for (int ai = 0; ai < 2; ++ai) {
            u32x4 b[4][2]; unsigned long long sv[4];
#pragma unroll
            for (int m = 0; m < 4; ++m) { const bf16_t* bp = xb + (size_t)(row0 + ai * HALF + m * 16) * ldc + col0;
#pragma unroll
                for (int bj = 0; bj < 2; ++bj) b[m][bj] = *(const u32x4*)(bp + bj * HALF);
                sv[m] = ssin ? ssin[row0 + ai * HALF + m * 16] : 0ull; }
#pragma unroll
            for (int m = 0; m < 4; ++m) { const int row = row0 + ai * HALF + m * 16; bf16_t* xp = xb + (size_t)row * ldc + col0;
                const float sc = ssin ? 1.0f / ((float)sv[m] * (1.f / (16777216.f * 2048.f)) + 1e-6f) : 1.f;
                float q = 0.f;
#pragma unroll
                for (int bj = 0; bj < 2; ++bj) { f32x4 v0, v1;
#pragma unroll
                    for (int e = 0; e < 2; ++e) { v0[2 * e] = __builtin_bit_cast(float, b[m][bj][e] << 16); v0[2 * e + 1] = __builtin_bit_cast(float, b[m][bj][e] & 0xffff0000u);
                                                  v1[2 * e] = __builtin_bit_cast(float, b[m][bj][2 + e] << 16); v1[2 * e + 1] = __builtin_bit_cast(float, b[m][bj][2 + e] & 0xffff0000u); }
                    v0 += acc[ai][bj][m][0] * sc; v1 += acc[ai][bj][m][1] * sc;
                    q += ((v0[0] * v0[0] + v0[1] * v0[1]) + (v0[2] * v0[2] + v0[3] * v0[3])) + ((v1[0] * v1[0] + v1[1] * v1[1]) + (v1[2] * v1[2] + v1[3] * v1[3]));
                    if (outf) { float* op = outf + (size_t)row * ldc + col0 + bj * HALF; *(f32x4*)op = v0; *(f32x4*)(op + 4) = v1; }
                    else { u32x4 w; w.x = cvt_pk_bf16(v0[0], v0[1]); w.y = cvt_pk_bf16(v0[2], v0[3]); w.z = cvt_pk_bf16(v1[0], v1[1]); w.w = cvt_pk_bf16(v1[2], v1[3]); *(u32x4*)(xp + bj * HALF) = w; } }
                sq[ai][m] = q; }
            asm volatile("" ::: "memory");
        }
#pragma unroll
        for (int ai = 0; ai < 2; ++ai) {
#pragma unroll
            for (int m = 0; m < 4; ++m) { float q = sq[ai][m]; q += __shfl_xor(q, 16); q += __shfl_xor(q, 32); sq[ai][m] = q; }
            const float v = fq == 0 ? sq[ai][0] : (fq == 1 ? sq[ai][1] : (fq == 2 ? sq[ai][2] : sq[ai][3]));
            atomicAdd(ssout + (u.pm * BM + wr * 64 + ai * HALF + fq * 16 + fr), (unsigned long long)(v * 16777216.f)); }
    }
};

struct EpiQKV {
    static constexpr bool PERM = true, AFTER_DRAIN = false; static constexpr int NS = 16;
    bf16_t* O; int ldc; const PG8_LAS float* varl; PG8_LAS float* red; int pm0, pm1; const unsigned long long* ss; const PG8_LAS float* gql;
    __device__ __forceinline__ void operator()(const f32x4 (&acc)[2][2][4][2], const Unit& u, int wr, int wc, int fr, int fq) const {
        const int row0 = u.pm * BM + wr * 64 + fr, col0 = u.pn * BM + wc * 32 + 8 * fq;
        const int kind = u.pn >> 3;
        float sc[2][2][4];
#pragma unroll
        for (int ai = 0; ai < 2; ++ai)
#pragma unroll
            for (int bj = 0; bj < 2; ++bj)
#pragma unroll
                for (int m = 0; m < 4; ++m) sc[ai][bj][m] = 1.f;
        {
            float var[2][4];
            const int slot = u.pm == pm0 ? 0 : (u.pm == pm1 ? 1 : -1);
#pragma unroll
            for (int ai = 0; ai < 2; ++ai)
#pragma unroll
                for (int m = 0; m < 4; ++m) { const int rl = ai * HALF + wr * 64 + m * 16 + fr;
                    var[ai][m] = slot >= 0 ? varl[slot * BM + rl] : (float)ss[u.pm * BM + rl] * (1.f / (16777216.f * 2048.f)) + 1e-6f; }
            if (kind != 2) {
#pragma unroll
                for (int ai = 0; ai < 2; ++ai)
#pragma unroll
                    for (int bj = 0; bj < 2; ++bj)
#pragma unroll
                        for (int m = 0; m < 4; ++m) { const f32x4 a = acc[ai][bj][m][0], b = acc[ai][bj][m][1];
                            float q = ((a[0] * a[0] + a[1] * a[1]) + (a[2] * a[2] + a[3] * a[3])) + ((b[0] * b[0] + b[1] * b[1]) + (b[2] * b[2] + b[3] * b[3]));
                            q += __shfl_xor(q, 16); q += __shfl_xor(q, 32);
                            if (fq == 0) red[((ai * HALF + wr * 64 + m * 16 + fr) * 2 + bj) * 4 + wc] = q; }
                asm volatile("s_waitcnt lgkmcnt(0)" ::: "memory");
                __builtin_amdgcn_s_barrier();
#pragma unroll
                for (int ai = 0; ai < 2; ++ai)
#pragma unroll
                    for (int bj = 0; bj < 2; ++bj)
#pragma unroll
                        for (int m = 0; m < 4; ++m) { const f32x4 r4 = *(const PG8_LAS f32x4*)(red + ((ai * HALF + wr * 64 + m * 16 + fr) * 2 + bj) * 4);
                            sc[ai][bj][m] = __builtin_amdgcn_rsqf(((r4[0] + r4[1]) + (r4[2] + r4[3])) * (1.f / 128.f) + 1e-6f * var[ai][m]); }
            } else {
#pragma unroll
                for (int ai = 0; ai < 2; ++ai)
#pragma unroll
                    for (int m = 0; m < 4; ++m) { const float r = __builtin_amdgcn_rsqf(var[ai][m]); sc[ai][0][m] = r; sc[ai][1][m] = r; }
            }
        }
        if (kind == 0) {
            const f32x4 g0 = *(const PG8_LAS f32x4*)(gql + wc * 32 + 8 * fq), g1 = *(const PG8_LAS f32x4*)(gql + wc * 32 + 8 * fq + 4);
#pragma unroll
            for (int ai = 0; ai < 2; ++ai)
#pragma unroll
                for (int m = 0; m < 4; ++m) { bf16_t* rowp = O + (size_t)(row0 + ai * HALF + m * 16) * ldc + col0;
#pragma unroll
                    for (int bj = 0; bj < 2; ++bj) { const f32x4 v0 = acc[ai][bj][m][0] * sc[ai][bj][m] * g0, v1 = acc[ai][bj][m][1] * sc[ai][bj][m] * g1;
                        u32x4 w; w.x = cvt_pk_bf16(v0[0], v0[1]); w.y = cvt_pk_bf16(v0[2], v0[3]); w.z = cvt_pk_bf16(v1[0], v1[1]); w.w = cvt_pk_bf16(v1[2], v1[3]);
                        *(u32x4*)(rowp + bj * HALF) = w; } }
        } else {
#pragma unroll
            for (int ai = 0; ai < 2; ++ai)
#pragma unroll
                for (int m = 0; m < 4; ++m) { bf16_t* rowp = O + (size_t)(row0 + ai * HALF + m * 16) * ldc + col0;
#pragma unroll
                    for (int bj = 0; bj < 2; ++bj) { const f32x4 v0 = acc[ai][bj][m][0] * sc[ai][bj][m], v1 = acc[ai][bj][m][1] * sc[ai][bj][m];
                        u32x4 w; w.x = cvt_pk_bf16(v0[0], v0[1]); w.y = cvt_pk_bf16(v0[2], v0[3]); w.z = cvt_pk_bf16(v1[0], v1[1]); w.w = cvt_pk_bf16(v1[2], v1[3]);
                        *(u32x4*)(rowp + bj * HALF) = w; } }
        }
    }
};
template <class Epi, class Sched, bool ALIGN_EPI = false, bool SP2 = false>
__device__ __forceinline__ void gemm_phase(PG8_LAS unsigned char* lds, const Gemm g, const Sched& S, const Epi& E) {
    int tid_l = threadIdx.x; asm volatile("" : "+v"(tid_l));
    const int tid = tid_l, wid = __builtin_amdgcn_readfirstlane(tid >> 6), lane = tid & 63, wr = wid >> 2, wc = wid & 3, fr = lane & 15, fq = lane >> 4;
    const int K = g.K, nt = K / BK, LD = g.ld ? g.ld : g.K;
    unsigned voffA[2], voffB[2];
#pragma unroll
    for (int i = 0; i < 2; ++i) { int R, C; stage_rc(tid * 16 + i * 8192, R, C); const int Rb = Epi::PERM ? ((R & ~31) + perm32(R & 31)) : R;
        voffA[i] = (unsigned)(R * LD + C) * 2u; voffB[i] = (unsigned)(Rb * LD + C) * 2u; }
    const size_t kstep = (size_t)(BK * 2);
    const size_t hstep = (size_t)HALF * LD * 2;
    const size_t tstep = 2 * hstep;
    const unsigned ldsw = (unsigned)wid * 1024u;
    const int aoff = lds_byte(wr * 64 + fr, fq * 8), boff = lds_byte(wc * 32 + fr, fq * 8);
#define PG8_SA(b, h) (((b) * 2 + (h)) * HTB)
#define PG8_SB(b, h) ((4 + (b) * 2 + (h)) * HTB)
#define PG8_STAGE(bufoff, gbase, voff) do { _Pragma("unroll") for (int _i = 0; _i < 2; ++_i) \
        __builtin_amdgcn_global_load_lds((const unsigned*)((const char*)(gbase) + (voff)[_i]), (PG8_LAS unsigned*)(lds + (bufoff) + ldsw + _i * 8192), 16, 0, 0); } while (0)
#define PG8_LDA(dst, b, h) do { _Pragma("unroll") for (int m = 0; m < 4; ++m) _Pragma("unroll") for (int k = 0; k < 2; ++k) dst[m][k] = *(const PG8_LAS bf16x8*)(lds + PG8_SA(b, h) + aoff + m * 2048 + k * 1024); } while (0)
#define PG8_LDB(dst, b, h) do { _Pragma("unroll") for (int n = 0; n < 2; ++n) _Pragma("unroll") for (int k = 0; k < 2; ++k) dst[n][k] = *(const PG8_LAS bf16x8*)(lds + PG8_SB(b, h) + boff + n * 2048 + k * 1024); } while (0)
#define PG8_MMA(ai, bj, At, Bt) do { __builtin_amdgcn_s_setprio(1); _Pragma("unroll") for (int m = 0; m < 4; ++m) _Pragma("unroll") for (int n = 0; n < 2; ++n) _Pragma("unroll") for (int k = 0; k < 2; ++k) \
        acc[ai][bj][m][n] = __builtin_amdgcn_mfma_f32_16x16x32_bf16(Bt[n][k], At[m][k], acc[ai][bj][m][n], 0, 0, 0); __builtin_amdgcn_s_setprio(0); } while (0)
#define PG8_WAIT_V(n) asm volatile("s_waitcnt vmcnt(" #n ")" ::: "memory")
#define PG8_WAIT_L(n) asm volatile("s_waitcnt lgkmcnt(" #n ")" ::: "memory")
#define PG8_BAR __builtin_amdgcn_s_barrier()
#define PG8_SCHED __builtin_amdgcn_sched_barrier(0)
    Unit cur, nxt; int ui = 0;
    if (!S.next(0, cur)) return;
    f32x4 acc[2][2][4][2];
#pragma unroll
    for (int a = 0; a < 2; ++a)
#pragma unroll
        for (int b = 0; b < 2; ++b)
#pragma unroll
            for (int m = 0; m < 4; ++m)
#pragma unroll
                for (int n = 0; n < 2; ++n) acc[a][b][m][n] = (f32x4){0.f, 0.f, 0.f, 0.f};
    bf16x8 At[4][2], B0[2][2], B1[2][2];
    const char* cA = (const char*)g.A + (size_t)cur.pm * tstep + (size_t)cur.ko * 2; const char* cB = (const char*)g.Bt + (size_t)cur.pn * tstep + (size_t)cur.ko * 2;
    S.a_ready(cur);
    if constexpr (SP2) {
        PG8_STAGE(PG8_SB(0, 0), cB, voffB); PG8_STAGE(PG8_SB(0, 1), cB + hstep, voffB); PG8_STAGE(PG8_SA(0, 0), cA, voffA); PG8_STAGE(PG8_SA(0, 1), cA + hstep, voffA);
        if (wr == 1) PG8_BAR;
        PG8_WAIT_V(2); PG8_BAR;
        PG8_STAGE(PG8_SB(1, 0), cB + kstep, voffB); PG8_STAGE(PG8_SA(1, 0), cA + kstep, voffA); PG8_STAGE(PG8_SB(1, 1), cB + hstep + kstep, voffB);
        PG8_WAIT_V(6); PG8_BAR;
    } else {
        PG8_STAGE(PG8_SB(0, 0), cB, voffB); PG8_STAGE(PG8_SA(0, 0), cA, voffA); PG8_STAGE(PG8_SB(0, 1), cB + hstep, voffB); PG8_STAGE(PG8_SA(0, 1), cA + hstep, voffA);
        if (wr == 1) PG8_BAR;
        PG8_WAIT_V(4); PG8_BAR;
        PG8_STAGE(PG8_SB(1, 0), cB + kstep, voffB); PG8_STAGE(PG8_SA(1, 0), cA + kstep, voffA); PG8_STAGE(PG8_SB(1, 1), cB + hstep + kstep, voffB);
        PG8_WAIT_V(6); PG8_BAR;
    }
    for (;;) {
        const bool has_next = S.next(ui + 1, nxt);
        const char* nA = has_next ? (const char*)g.A + (size_t)nxt.pm * tstep + (size_t)nxt.ko * 2 : cA; const char* nB = has_next ? (const char*)g.Bt + (size_t)nxt.pn * tstep + (size_t)nxt.ko * 2 : cB;
        for (int t = 0; t < nt; t += 2) {
            const bool last = (t == nt - 2);
            const char* a1 = cA + (size_t)(t + 1) * kstep;
            const char* a2 = last ? nA : cA + (size_t)(t + 2) * kstep; const char* b2 = last ? nB : cB + (size_t)(t + 2) * kstep;
            const char* a3 = a2 + kstep; const char* b3 = b2 + kstep;
            if (last && has_next) S.a_ready(nxt);
            if constexpr (SP2) {
            PG8_LDB(B0, 0, 0); PG8_LDB(B1, 0, 1); PG8_SCHED; PG8_LDA(At, 0, 0); PG8_STAGE(PG8_SA(1, 1), a1 + hstep, voffA);
            PG8_WAIT_V(8); PG8_WAIT_L(0); PG8_BAR; PG8_MMA(0, 0, At, B0); PG8_MMA(0, 1, At, B1); PG8_BAR; PG8_SCHED;
            PG8_LDA(At, 0, 1); PG8_STAGE(PG8_SB(0, 0), b2, voffB); PG8_STAGE(PG8_SB(0, 1), b2 + hstep, voffB); PG8_STAGE(PG8_SA(0, 0), a2, voffA);
            PG8_WAIT_V(8); PG8_WAIT_L(0); PG8_BAR; PG8_MMA(1, 0, At, B0); PG8_MMA(1, 1, At, B1); PG8_BAR; PG8_SCHED;
            PG8_LDB(B0, 1, 0); PG8_LDB(B1, 1, 1); PG8_SCHED; PG8_LDA(At, 1, 0); PG8_STAGE(PG8_SA(0, 1), a2 + hstep, voffA);
            PG8_WAIT_V(8); PG8_WAIT_L(0); PG8_BAR; PG8_MMA(0, 0, At, B0); PG8_MMA(0, 1, At, B1); PG8_BAR; PG8_SCHED;
            PG8_LDA(At, 1, 1); PG8_STAGE(PG8_SB(1, 0), b3, voffB); PG8_STAGE(PG8_SB(1, 1), b3 + hstep, voffB); PG8_STAGE(PG8_SA(1, 0), a3, voffA);
            PG8_WAIT_V(8); PG8_WAIT_L(0); PG8_BAR; PG8_MMA(1, 0, At, B0); PG8_MMA(1, 1, At, B1); PG8_BAR; PG8_SCHED;
            } else {
            PG8_LDB(B0, 0, 0); PG8_SCHED; PG8_LDA(At, 0, 0); PG8_STAGE(PG8_SA(1, 1), a1 + hstep, voffA);
            PG8_WAIT_L(8); PG8_BAR; PG8_WAIT_L(0); PG8_MMA(0, 0, At, B0); PG8_BAR; PG8_SCHED;
            PG8_LDB(B1, 0, 1); PG8_STAGE(PG8_SB(0, 0), b2, voffB);
            PG8_BAR; PG8_WAIT_L(0); PG8_MMA(0, 1, At, B1); PG8_BAR;
            PG8_LDA(At, 0, 1); PG8_STAGE(PG8_SA(0, 0), a2, voffA);
            PG8_BAR; PG8_WAIT_L(0); PG8_MMA(1, 0, At, B0); PG8_BAR; PG8_SCHED;
            PG8_STAGE(PG8_SB(0, 1), b2 + hstep, voffB);
            PG8_WAIT_V(6); PG8_BAR; PG8_MMA(1, 1, At, B1); PG8_BAR;
            PG8_LDB(B0, 1, 0); PG8_SCHED; PG8_LDA(At, 1, 0); PG8_STAGE(PG8_SA(0, 1), a2 + hstep, voffA);
            PG8_WAIT_L(8); PG8_BAR; PG8_WAIT_L(0); PG8_MMA(0, 0, At, B0); PG8_BAR; PG8_SCHED;
            PG8_LDB(B1, 1, 1); PG8_STAGE(PG8_SB(1, 0), b3, voffB);
            PG8_BAR; PG8_WAIT_L(0); PG8_MMA(0, 1, At, B1); PG8_BAR;
            PG8_LDA(At, 1, 1); PG8_STAGE(PG8_SA(1, 0), a3, voffA);
            PG8_BAR; PG8_WAIT_L(0); PG8_MMA(1, 0, At, B0); PG8_BAR; PG8_SCHED;
            PG8_STAGE(PG8_SB(1, 1), b3 + hstep, voffB);
            PG8_WAIT_V(6); PG8_BAR; PG8_MMA(1, 1, At, B1); PG8_BAR;
            }
        }
        if constexpr (ALIGN_EPI) { if (wr == 0) PG8_BAR; }
        if constexpr (!Epi::AFTER_DRAIN) { E(acc, cur, wr, wc, fr, fq); S.done(cur); }
        if (!has_next) break;
#pragma unroll
        for (int a = 0; a < 2; ++a)
#pragma unroll
            for (int b = 0; b < 2; ++b)
#pragma unroll
                for (int m = 0; m < 4; ++m)
#pragma unroll
                    for (int n = 0; n < 2; ++n) acc[a][b][m][n] = (f32x4){0.f, 0.f, 0.f, 0.f};
        cur = nxt; cA = nA; cB = nB; ++ui;
        if constexpr (ALIGN_EPI) { if (wr == 1) PG8_BAR; }
    }
    PG8_WAIT_V(0);
    if constexpr (!ALIGN_EPI) { if (wr == 0) PG8_BAR; }
    PG8_BAR;
    if constexpr (Epi::AFTER_DRAIN) { E.fused(acc, cur, wr, wc, fr, fq, lds, wid, lane); S.done(cur); }
#undef PG8_SA
#undef PG8_SB
#undef PG8_STAGE
#undef PG8_LDA
#undef PG8_LDB
#undef PG8_MMA
#undef PG8_WAIT_V
#undef PG8_WAIT_L
#undef PG8_BAR
#undef PG8_SCHED
}
}
constexpr int NWAVES = 8;
constexpr int DM = 2048, MTOK = 16384, DFF = 8192, HD = 128, NHEAD = 16, XHEAD = 4, NMEM = 256;
constexpr int S_P = 8192, S_S = 2048;
constexpr int MEMROWS = 5 * NMEM;
constexpr int NQKV = 3 * DM;
constexpr float RMS_EPS = 1e-6f;
constexpr float ATTN_SCALE = 0.08838834764831845f;
constexpr float LOG2E = 1.4426950408889634f;

constexpr size_t MiB = 1u << 20;
constexpr size_t WS_CTL = 0, CTL_ZERO_BYTES = 1 * MiB;
constexpr size_t WS_LSE = 1 * MiB;
constexpr size_t WS_SS = 4 * MiB;
typedef unsigned long long u64;
constexpr float SS_SCALE = 16777216.f, SS_INV = 1.f / (16777216.f * 2048.f);
constexpr size_t WS_WQKVA = 16 * MiB;
constexpr size_t WS_WQKVB = 64 * MiB;
constexpr size_t WS_WOA = 208 * MiB, WS_WOB = 224 * MiB;
constexpr size_t WS_WQX = 240 * MiB;
constexpr size_t WS_WKVX = 248 * MiB;
constexpr size_t WS_WOX = 264 * MiB;
constexpr size_t WS_WUP = 272 * MiB;
constexpr size_t WS_WDN = 400 * MiB;
constexpr size_t WS_H = 528 * MiB;
constexpr size_t WS_O = 592 * MiB;
constexpr size_t WS_XQ = 656 * MiB, WS_XO = 672 * MiB;
constexpr size_t WS_KVM = 688 * MiB;
constexpr size_t WS_QKV = 704 * MiB;
constexpr size_t WS_OG = 896 * MiB;
constexpr size_t WS_HID = 704 * MiB;
constexpr size_t WS_XQ2 = 1088 * MiB;
constexpr size_t WS_END = 1104 * MiB;
constexpr int CW_BAR = 4096;

constexpr int RING_OFF = 0, RING_BYTES = 131072;
constexpr int LDSCTL_OFF = RING_BYTES, MISC_OFF = LDSCTL_OFF + 320;
constexpr int LDS_BYTES = 147456;

#define GAS __attribute__((address_space(1)))
#define LAS __attribute__((address_space(3)))
typedef unsigned short bf16;
typedef unsigned v4u __attribute__((ext_vector_type(4)));
typedef unsigned v2u __attribute__((ext_vector_type(2)));
typedef float f32x4 __attribute__((ext_vector_type(4)));
typedef GAS unsigned gu32;
#define LDS_WAIT() asm volatile("s_waitcnt lgkmcnt(0)" ::: "memory")
#define VM_WAIT() asm volatile("s_waitcnt vmcnt(0)" ::: "memory")
__device__ __forceinline__ unsigned f2bf(float f) { unsigned u = __builtin_bit_cast(unsigned, f); return (u + 0x7fffu + ((u >> 16) & 1u)) >> 16; }
__device__ __forceinline__ unsigned pk2(float lo, float hi) { return f2bf(lo) | (f2bf(hi) << 16); }
__device__ __forceinline__ float bflo(unsigned w) { return __builtin_bit_cast(float, w << 16); }
__device__ __forceinline__ float bfhi(unsigned w) { return __builtin_bit_cast(float, w & 0xffff0000u); }
__device__ __forceinline__ float wave_sum(float v) {
#pragma unroll
    for (int o = 1; o < 64; o <<= 1) v += __shfl_xor(v, o);
    return v;
}
__device__ __forceinline__ float wave_max(float v) {
#pragma unroll
    for (int o = 1; o < 64; o <<= 1) v = fmaxf(v, __shfl_xor(v, o));
    return v;
}
__device__ __forceinline__ void seq_of(int m, int& sb, int& len) { if (m < S_P) { sb = 0; len = S_P; } else { sb = S_P + ((m - S_P) & ~(S_S - 1)); len = S_S; } }

#define XB_TMO      128
#define XB_XCNT(j)  (256  + 64 * (j))
#define XB_XSUB(j)  (1280 + 64 * (j))
#define XB_XGEN(j)  (2304 + 64 * (j))
#define XB_TOP      3328
#define XB_TOPGEN   3392
#define XCD_BAR_WORDS 3456
#define XB_SPIN_CAP (1u << 18)

__device__ __forceinline__ unsigned xb_ld(unsigned* p)              { return __hip_atomic_load(p, __ATOMIC_RELAXED, __HIP_MEMORY_SCOPE_AGENT); }
__device__ __forceinline__ unsigned xb_add(unsigned* p, unsigned v) { return __hip_atomic_fetch_add(p, v, __ATOMIC_RELAXED, __HIP_MEMORY_SCOPE_AGENT); }
__device__ __forceinline__ unsigned xb_xcc_id() { return (unsigned)__builtin_amdgcn_s_getreg((3 << 11) | 20) & 0xFu; }
#define XB_SPIN(cond, bar) do { unsigned _sp = 0; while (cond) { __builtin_amdgcn_s_sleep(1); \
    if ((++_sp & 255u) == 0u) { if (xb_ld(&(bar)[XB_TMO])) break; if (_sp > XB_SPIN_CAP) { atomicAdd(&(bar)[XB_TMO], 1u); break; } } } } while (0)

struct XcdBarrier {
    unsigned* bar; unsigned x;
    volatile LAS unsigned* st;
};

__device__ __forceinline__ XcdBarrier xcd_barrier_post(unsigned* bar, volatile LAS unsigned* st) {
    XcdBarrier b; b.bar = bar; b.x = xb_xcc_id(); b.st = st;
    if (threadIdx.x == 0) (void)xb_add(&bar[XB_XCNT(b.x)], 1u);
    return b;
}
__device__ __forceinline__ void xcd_barrier_complete(unsigned* bar, unsigned x, unsigned& nloc, unsigned& nx) {
    const unsigned G = gridDim.x * gridDim.y * gridDim.z;
    unsigned sum, cnt, mine, sp = 0u;
    for (;;) {
        sum = 0u; cnt = 0u; mine = 0u;
#pragma unroll
        for (unsigned j = 0; j < 16; ++j) { const unsigned c = xb_ld(&bar[XB_XCNT(j)]); sum += c; cnt += (c > 0u) ? 1u : 0u; mine = (j == x) ? c : mine; }
        if (sum == G) break;
        __builtin_amdgcn_s_sleep(1);
        if ((++sp & 255u) == 0u) { if (xb_ld(&bar[XB_TMO])) break; if (sp > XB_SPIN_CAP) { atomicAdd(&bar[XB_TMO], 1u); break; } }
    }
    nloc = mine > 0u ? mine : 1u; nx = cnt > 0u ? cnt : 1u;
}

__device__ __forceinline__ void xcd_barrier(const XcdBarrier& b) {
    asm volatile("s_waitcnt vmcnt(0)" ::: "memory");
    __syncthreads();
    if (threadIdx.x == 0) {
        unsigned* bar = b.bar;
        __builtin_amdgcn_s_waitcnt(0);
        unsigned nloc = b.st[0], nx = b.st[1];
        if (nloc == 0u) { xcd_barrier_complete(bar, b.x, nloc, nx); b.st[0] = nloc; b.st[1] = nx; }
        const unsigned old = xb_add(&bar[XB_XSUB(b.x)], 1u);
        const unsigned gen = old / nloc;
        if (old + 1u == (gen + 1u) * nloc) {
            __builtin_amdgcn_fence(__ATOMIC_RELEASE, "agent");
            asm volatile("s_waitcnt vmcnt(0)" ::: "memory");
            const unsigned og = xb_add(&bar[XB_TOP], 1u);
            const unsigned tg = og / nx;
            if (og + 1u == (tg + 1u) * nx) xb_add(&bar[XB_TOPGEN], 1u);
            else XB_SPIN(xb_ld(&bar[XB_TOPGEN]) == tg, bar);
            __builtin_amdgcn_fence(__ATOMIC_ACQUIRE, "agent");
            xb_add(&bar[XB_XGEN(b.x)], 1u);
            asm volatile("s_waitcnt vmcnt(0)" ::: "memory");
        } else {
            XB_SPIN(xb_ld(&bar[XB_XGEN(b.x)]) == gen, bar);
            __builtin_amdgcn_fence(__ATOMIC_ACQUIRE, "agent");
            asm volatile("s_waitcnt vmcnt(0)" ::: "memory");
        }
    }
    __syncthreads();
}

__device__ __forceinline__ void transpose_item(const float* W, const float* g  , int K, int N, bf16* WT, LAS float* scr, int kb, int nb, int lane) {
    const int k0 = 64 * kb, n0 = 32 * nb;
#pragma unroll 8
    for (int i = 0; i < 32; ++i) { const int kk = 2 * i + (lane >> 5); const float gv = g ? g[k0 + kk] : 1.f; scr[kk * 33 + (lane & 31)] = W[(size_t)(k0 + kk) * N + n0 + (lane & 31)] * gv; }
    LDS_WAIT(); asm volatile("" ::: "memory");
    const int c = lane & 7;
#pragma unroll
    for (int j = 0; j < 4; ++j) { const int n = (lane >> 3) + 8 * j; const LAS float* s = scr + (8 * c) * 33 + n;
        v4u o; o.x = pk2(s[0 * 33], s[1 * 33]); o.y = pk2(s[2 * 33], s[3 * 33]); o.z = pk2(s[4 * 33], s[5 * 33]); o.w = pk2(s[6 * 33], s[7 * 33]);
        *(GAS v4u*)(WT + (size_t)(n0 + n) * K + k0 + 8 * c) = o; }
    LDS_WAIT(); asm volatile("" ::: "memory");
}
__device__ __forceinline__ void transpose_tensor(const float* W, const float* g, int gstep, int nl, int K, int N, bf16* WT, LAS float* scr, int gw, int NGW, int lane) {
    const int nblk = N / 32, per = (K / 64) * nblk, total = nl * per;
    for (int it = gw; it < total; it += NGW) { const int l = it / per, r = it - l * per;
        transpose_item(W + (size_t)l * K * N, g ? g + (size_t)l * gstep : nullptr, K, N, WT + (size_t)l * K * N, scr, r / nblk, r % nblk, lane); }
}
__device__ __forceinline__ void rms_row_to_bf16(const float* xrow, const float* g, bf16* orow, int lane) {
    const GAS f32x4* xr = (const GAS f32x4*)xrow + lane; const GAS f32x4* gr = (const GAS f32x4*)g + lane;
    f32x4 v[8]; float s = 0.f;
#pragma unroll
    for (int j = 0; j < 8; ++j) { v[j] = xr[64 * j]; s += (v[j].x * v[j].x + v[j].y * v[j].y) + (v[j].z * v[j].z + v[j].w * v[j].w); }
    const float rstd = 1.0f / sqrtf(wave_sum(s) * (1.f / DM) + RMS_EPS);
    GAS v2u* o8 = (GAS v2u*)orow + lane;
#pragma unroll
    for (int j = 0; j < 8; ++j) { const f32x4 gv = gr[64 * j]; v2u o; o.x = pk2(v[j].x * rstd * gv.x, v[j].y * rstd * gv.y); o.y = pk2(v[j].z * rstd * gv.z, v[j].w * rstd * gv.w); o8[64 * j] = o; }
}
__device__ __forceinline__ void row_to_bf16_ss(const float* xrow, bf16* orow, u64* ss, int lane) {
    const GAS f32x4* xr = (const GAS f32x4*)xrow + lane; f32x4 v[8]; float s = 0.f;
#pragma unroll
    for (int j = 0; j < 8; ++j) { v[j] = xr[64 * j]; s += (v[j].x * v[j].x + v[j].y * v[j].y) + (v[j].z * v[j].z + v[j].w * v[j].w); }
    s = wave_sum(s);
    GAS v2u* o8 = (GAS v2u*)orow + lane;
#pragma unroll
    for (int j = 0; j < 8; ++j) { v2u o; o.x = pk2(v[j].x, v[j].y); o.y = pk2(v[j].z, v[j].w); o8[64 * j] = o; }
    if (lane == 0) *ss = (u64)(s * SS_SCALE);
}
__device__ __forceinline__ void norm_phase(const float* x0, const float* x1, int sub1, const float* g, bf16* H, int gw, int NGW, int lane) {
    for (int m = gw; m < MTOK; m += NGW) { const float* xr = (m < S_P) ? x0 + (size_t)m * DM : x1 + (size_t)(m - sub1) * DM; rms_row_to_bf16(xr, g, H + (size_t)m * DM, lane); }
}
__device__ __forceinline__ void merge_phase(const bf16* OG, const float* LSE, bf16* O, int gtid, int NT) {
    for (int idx = gtid; idx < MTOK * (DM / 8); idx += NT) {
        const int m = idx >> 8, col = (idx & 255) * 8, h = col >> 7;
        const float l0 = LSE[(size_t)m * 16 + h], l1 = LSE[(size_t)MTOK * 16 + (size_t)m * 16 + h], l2 = LSE[(size_t)2 * MTOK * 16 + (size_t)m * 16 + h];
        const float mx = fmaxf(l0, fmaxf(l1, l2)); float w0 = __expf(l0 - mx), w1 = __expf(l1 - mx), w2 = __expf(l2 - mx); const float inv = 1.f / (w0 + w1 + w2); w0 *= inv; w1 *= inv; w2 *= inv;
        const size_t off = (size_t)m * DM + col;
        const v4u a = *(const GAS v4u*)(OG + off), b = *(const GAS v4u*)(OG + (size_t)MTOK * DM + off), c = *(const GAS v4u*)(OG + (size_t)2 * MTOK * DM + off);
        v4u o;
#pragma unroll
        for (int e = 0; e < 4; ++e) { const float lo = w0 * bflo(a[e]) + w1 * bflo(b[e]) + w2 * bflo(c[e]), hi = w0 * bfhi(a[e]) + w1 * bfhi(b[e]) + w2 * bfhi(c[e]); o[e] = pk2(lo, hi); }
        *(GAS v4u*)(O + off) = o;
    }
}

__device__ const unsigned char T5B[3][132] = {
 {11,11,11,11,11,11,11,11,11,11,11,11,11,11,11,10,10,10,10,10,10,10,10,10,10,10,10,10,10,10,10,10,10,10,10,10,10,10,9,9,9,9,9,9,9,9,9,9,9,9,8,8,8,8,8,8,8,7,6,5,4,3,2,1,0,17,18,19,20,21,22,23,24,24,24,24,24,24,24,25,25,25,25,25,25,25,25,25,25,25,25,26,26,26,26,26,26,26,26,26,26,26,26,26,26,26,26,26,26,26,26,26,26,26,27,27,27,27,27,27,27,27,27,27,27,27,27,27,27,0,0,0},
 {13,13,13,13,13,13,13,13,13,13,13,13,13,13,13,13,13,13,13,13,13,13,13,12,12,12,12,12,12,12,12,12,12,12,12,12,12,12,12,12,12,12,11,11,11,11,11,11,11,11,11,11,10,10,10,10,10,10,9,9,9,8,8,4,0,20,24,24,25,25,25,26,26,26,26,26,26,27,27,27,27,27,27,27,27,27,27,28,28,28,28,28,28,28,28,28,28,28,28,28,28,28,28,28,28,28,29,29,29,29,29,29,29,29,29,29,29,29,29,29,29,29,29,29,29,29,29,29,29,0,0,0},
 {15,15,15,15,15,15,15,15,15,15,15,15,15,15,15,15,15,15,15,15,15,15,15,15,15,15,15,15,15,15,14,14,14,14,14,14,14,14,14,14,14,14,14,14,14,13,13,13,13,13,13,13,13,13,12,12,12,12,12,11,11,10,10,9,0,25,26,26,27,27,28,28,28,28,28,29,29,29,29,29,29,29,29,29,30,30,30,30,30,30,30,30,30,30,30,30,30,30,30,31,31,31,31,31,31,31,31,31,31,31,31,31,31,31,31,31,31,31,31,31,31,31,31,31,31,31,31,31,31,0,0,0}};

struct NaiveNA {
    static constexpr int NHEADS = NHEAD, NCAND = 128;
    const bf16* Q; const bf16* K; const bf16* V; int ld; const float* qn; const float* kn; const float* rpb  ; bf16* O; int ldo; float* lse;
    __device__ __forceinline__ void cand(int m, int h, int j, int& ktok, float& bias, bool& valid) const {
        int sb, len; seq_of(m, sb, len); const int pos = m - sb, rows = len >> 6, r = pos >> 6, c = pos & 63;
        int rs = r - 4; rs = rs < 0 ? 0 : (rs > rows - 8 ? rows - 8 : rs); int cs = c - 8; cs = cs < 0 ? 0 : (cs > 48 ? 48 : cs);
        const int kr = rs + (j >> 4), kc = cs + (j & 15); ktok = sb + kr * 64 + kc;
        int dc = kc - c; dc = dc < -15 ? -15 : (dc > 15 ? 15 : dc);
        bias = rpb[(h * 15 + (kr - r + 7)) * 31 + dc + 15]; valid = j < NCAND;
        if (!valid) { ktok = m; bias = 0.f; }
    }
};
struct NaiveDil {
    static constexpr int NHEADS = NHEAD, NCAND = 129;
    const bf16* Q; const bf16* K; const bf16* V; int ld; const float* qn; const float* kn; const float* t5  ; int g, dil; bf16* O; int ldo; float* lse;
    __device__ __forceinline__ void cand(int m, int h, int j, int& ktok, float& bias, bool& valid) const {
        int sb, len; seq_of(m, sb, len); const int pos = m - sb, t = pos / dil, rho = pos - t * dil, L = len / dil;
        const int kt = t + j - 64; valid = (j < NCAND) && kt >= 0 && kt < L; ktok = valid ? sb + kt * dil + rho : m;
        bias = valid ? t5[(int)T5B[g][j] * 48 + g * 16 + h] : 0.f;
    }
};
struct NaiveX {
    static constexpr int NHEADS = XHEAD, NCAND = 256;
    const bf16* Q; const bf16* K; const bf16* V; int ld  ; const float* qn; const float* kn; bf16* O; int ldo; float* lse; int ldq;
    __device__ __forceinline__ void cand(int m, int h, int j, int& ktok, float& bias, bool& valid) const {
        const int b = m < S_P ? 0 : 1 + ((m - S_P) >> 11); ktok = b * NMEM + j; bias = 0.f; valid = true;
    }
};
template <class P, int LDQ> __device__ __forceinline__ void attn_naive(const P& p, int gw, int NGW, int lane) {
    constexpr int NC = (P::NCAND + 63) / 64;
    for (int task = gw; task < MTOK * P::NHEADS; task += NGW) {
        const int m = task / P::NHEADS, h = task - m * P::NHEADS;
        const unsigned qw = *(const GAS unsigned*)(p.Q + (size_t)m * LDQ + h * HD + 2 * lane);
        float q0 = bflo(qw), q1 = bfhi(qw);
        const float rq = 1.0f / sqrtf(wave_sum(q0 * q0 + q1 * q1) * (1.f / HD) + RMS_EPS);
        q0 *= rq * p.qn[2 * lane] * p.kn[2 * lane] * ATTN_SCALE; q1 *= rq * p.qn[2 * lane + 1] * p.kn[2 * lane + 1] * ATTN_SCALE;
        int kt[NC]; float bias[NC], sc[NC]; bool valid[NC];
#pragma unroll
        for (int c = 0; c < NC; ++c) { p.cand(m, h, lane + 64 * c, kt[c], bias[c], valid[c]); sc[c] = 0.f; }
#pragma unroll
        for (int c = 0; c < NC; ++c) {
            const int nj = (P::NCAND - 64 * c) < 64 ? (P::NCAND - 64 * c) : 64;
            for (int jj = 0; jj < nj; ++jj) {
                const int ktok = __shfl(kt[c], jj);
                const unsigned kw = *(const GAS unsigned*)(p.K + (size_t)ktok * p.ld + h * HD + 2 * lane);
                const float k0 = bflo(kw), k1 = bfhi(kw);
                const float dot = wave_sum(q0 * k0 + q1 * k1), kss = wave_sum(k0 * k0 + k1 * k1);
                const float s = dot * (1.0f / sqrtf(kss * (1.f / HD) + RMS_EPS));
                if (lane == jj) sc[c] = s;
            }
        }
        float mx = -3.0e38f;
#pragma unroll
        for (int c = 0; c < NC; ++c) { sc[c] = valid[c] ? sc[c] + bias[c] : -1e30f; mx = fmaxf(mx, sc[c]); }
        mx = wave_max(mx); float l = 0.f;
#pragma unroll
        for (int c = 0; c < NC; ++c) { sc[c] = valid[c] ? __expf(sc[c] - mx) : 0.f; l += sc[c]; }
        l = wave_sum(l); const float inv = 1.f / l;
        float o0 = 0.f, o1 = 0.f;
#pragma unroll
        for (int c = 0; c < NC; ++c) {
            const int nj = (P::NCAND - 64 * c) < 64 ? (P::NCAND - 64 * c) : 64;
            for (int jj = 0; jj < nj; ++jj) {
                const int ktok = __shfl(kt[c], jj); const float pj = __shfl(sc[c], jj) * inv;
                const unsigned vw = *(const GAS unsigned*)(p.V + (size_t)ktok * p.ld + h * HD + 2 * lane);
                o0 += pj * bflo(vw); o1 += pj * bfhi(vw);
            }
        }
        *(GAS unsigned*)(p.O + (size_t)m * p.ldo + h * HD + 2 * lane) = pk2(o0, o1);
        if (p.lse != nullptr && lane == 0) p.lse[(size_t)m * 16 + h] = mx + __logf(l);
    }
}

namespace at {
using bf16x8 = __attribute__((ext_vector_type(8))) short;
using s16x4  = __attribute__((ext_vector_type(4))) short;
using f32x16 = __attribute__((ext_vector_type(16))) float;
using u32x4  = __attribute__((ext_vector_type(4))) unsigned;
#define KSWZ(row, colB) ((row) * 256 + ((colB) ^ (((row) & 7) << 4)))
#define SBAR() __builtin_amdgcn_sched_barrier(0)
constexpr int SHM_V = 16384, SHM_K = 16384;
constexpr int A_V = 0, A_K = 2 * SHM_V, A_OST = 65536;
constexpr int A_WS = LDSCTL_OFF + 1024, A_GQ = A_WS + 8 * 256, A_TB = A_GQ + 512, A_TB0 = A_TB + 256;
static_assert(A_TB0 + 4 * 640 <= LDS_BYTES, "attention LDS map");
constexpr float NEGM = -1e30f;
__device__ __forceinline__ int crow(int r, int hi) { return (r & 3) + 8 * (r >> 2) + 4 * hi; }
__device__ __forceinline__ unsigned cvtpk(float lo, float hi) { unsigned r; asm volatile("v_cvt_pk_bf16_f32 %0, %1, %2" : "=v"(r) : "v"(lo), "v"(hi)); return r; }
__device__ __forceinline__ float pl32_max(float v) { auto rr = __builtin_amdgcn_permlane32_swap(__float_as_uint(v), __float_as_uint(v), false, false); return fmaxf(__uint_as_float(rr[0]), __uint_as_float(rr[1])); }
__device__ __forceinline__ float pl32_sum(float v) { auto rr = __builtin_amdgcn_permlane32_swap(__float_as_uint(v), __float_as_uint(v), false, false); return __uint_as_float(rr[0]) + __uint_as_float(rr[1]); }
__device__ __forceinline__ int v_st(int k, int c) { const int kk = (k & ~0xC) | ((k & 4) << 1) | ((k & 8) >> 1); return ((kk >> 3) * 4 + (c >> 5)) * 512 + ((kk & 7) * 32 + (c & 31)) * 2; }
__device__ __forceinline__ int v_rd_base(int lane) { return ((lane & 3) << 3) | (((lane >> 2) & 3) << 6) | (((lane >> 4) & 1) << 5) | (((lane >> 5) & 1) << 8); }
constexpr int v_rd_off(int d0, int ks, int half) { return d0 * 512 + ks * 4096 + half * 2048; }
template <int OFF> __device__ __forceinline__ s16x4 tr_read(int vb) { s16x4 r; asm volatile("ds_read_b64_tr_b16 %0, %1 offset:%2" : "=&v"(r) : "v"(vb), "i"(OFF) : "memory"); return r; }
template <int D0, int SKIP = 0> __device__ __forceinline__ void pv_one(f32x16& od, int vb, bf16x8 pa0, bf16x8 pa1, bf16x8 pa2, bf16x8 pa3) {
  s16x4 l0 = {}, h0 = {}, l1 = {}, h1 = {}, l2 = {}, h2 = {}, l3 = {}, h3 = {};
  if (!(SKIP & 1)) { l0 = tr_read<v_rd_off(D0, 0, 0)>(vb); h0 = tr_read<v_rd_off(D0, 0, 1)>(vb); }
  if (!(SKIP & 2)) { l1 = tr_read<v_rd_off(D0, 1, 0)>(vb); h1 = tr_read<v_rd_off(D0, 1, 1)>(vb); }
  if (!(SKIP & 4)) { l2 = tr_read<v_rd_off(D0, 2, 0)>(vb); h2 = tr_read<v_rd_off(D0, 2, 1)>(vb); }
  if (!(SKIP & 8)) { l3 = tr_read<v_rd_off(D0, 3, 0)>(vb); h3 = tr_read<v_rd_off(D0, 3, 1)>(vb); }
  asm volatile("s_waitcnt lgkmcnt(0)" ::: "memory"); SBAR();
#define PK(L, H) (bf16x8){L[0], L[1], L[2], L[3], H[0], H[1], H[2], H[3]}
  if (!(SKIP & 1)) od = __builtin_amdgcn_mfma_f32_32x32x16_bf16(pa0, PK(l0, h0), od, 0, 0, 0);
  if (!(SKIP & 2)) od = __builtin_amdgcn_mfma_f32_32x32x16_bf16(pa1, PK(l1, h1), od, 0, 0, 0);
  if (!(SKIP & 4)) od = __builtin_amdgcn_mfma_f32_32x32x16_bf16(pa2, PK(l2, h2), od, 0, 0, 0);
  if (!(SKIP & 8)) od = __builtin_amdgcn_mfma_f32_32x32x16_bf16(pa3, PK(l3, h3), od, 0, 0, 0);
#undef PK
}
template <int V> struct IC { static constexpr int value = V; };
template <bool NB0 = true, bool NB1 = true> __device__ __forceinline__ void qkt(f32x16& p0, f32x16& p1, const LAS unsigned char* Ks, const LAS unsigned char* qst, const int (&kx)[4]) {
  bf16x8 kb0[2] = {}, kb1[2] = {}, qq[2];
#define QKT_LOAD(d0_, s_) do { const LAS unsigned char* kp_ = Ks + kx[(d0_) & 3] + ((d0_) >> 2) * 128; if (NB0) kb0[s_] = *(const LAS bf16x8*)kp_; if (NB1) kb1[s_] = *(const LAS bf16x8*)(kp_ + 8192); qq[s_] = *(const LAS bf16x8*)(qst + (d0_) * 1024); } while (0)
  QKT_LOAD(0, 0); QKT_LOAD(1, 1);
  SBAR();
#pragma unroll
  for (int d0 = 0; d0 < 8; ++d0) { const int sl = d0 & 1;
    if (NB0) p0 = __builtin_amdgcn_mfma_f32_32x32x16_bf16(kb0[sl], qq[sl], p0, 0, 0, 0);
    if (NB1) p1 = __builtin_amdgcn_mfma_f32_32x32x16_bf16(kb1[sl], qq[sl], p1, 0, 0, 0);
    SBAR();
    if (d0 + 2 < 8) { QKT_LOAD(d0 + 2, sl); SBAR(); } }
#undef QKT_LOAD
}
template <int CTRL> __device__ __forceinline__ float dppf(float v) { return __builtin_bit_cast(float, __builtin_amdgcn_update_dpp(0, __builtin_bit_cast(int, v), CTRL, 0xf, 0xf, true)); }
__device__ __forceinline__ float row16_sum(float v) { v += dppf<0xB1>(v); v += dppf<0x4E>(v); v += dppf<0x141>(v); v += dppf<0x140>(v); return v; }
__device__ __forceinline__ u32x4 knorm(u32x4 w, float epsv) {
  float f[8]; float ss = 0.f;
#pragma unroll
  for (int e = 0; e < 4; ++e) { f[2 * e] = bflo(w[e]); f[2 * e + 1] = bfhi(w[e]); ss += f[2 * e] * f[2 * e] + f[2 * e + 1] * f[2 * e + 1]; }
  ss = row16_sum(ss);
  const float rs = __builtin_amdgcn_rsqf(ss * (1.f / HD) + epsv);
  u32x4 o;
#pragma unroll
  for (int e = 0; e < 4; ++e) o[e] = cvtpk(f[2 * e] * rs, f[2 * e + 1] * rs);
  return o;
}
__device__ __forceinline__ float u64f(u64 v) { return (float)(unsigned)(v >> 32) * 4294967296.f + (float)(unsigned)v; }
__device__ __forceinline__ u32x4 vscale(u32x4 w, float sc) {
  u32x4 o;
#pragma unroll
  for (int e = 0; e < 4; ++e) o[e] = cvtpk(bflo(w[e]) * sc, bfhi(w[e]) * sc);
  return o;
}

struct PolNA {
  static constexpr bool HAS_BIAS = true, HAS_LSE = false, KV_RS = false, KV_PRE = true, Q_PRE = true, Q_PARTS2 = false, MASK_IN_TABLE = false; static constexpr int LVSET = 1; static constexpr int LDQ = NQKV, LDK = NQKV, LDO = DM, NUNITS = 1024, TB_LO = 0, TB_HI = 465;
  const bf16* Q; const bf16* K; const bf16* V; bf16* O; float* lse; const u64* ss; const float* qn; const float* kn; const float* rpb;
  int h, sb, r0, rows, kr0, T;
  __device__ __forceinline__ static int rs_of(int r, int rows) { int x = r - 4; return x < 0 ? 0 : (x > rows - 8 ? rows - 8 : x); }
  __device__ __forceinline__ void decode(int u) { h = u & 15; const int blk = u >> 4;
    if (blk < 32) { sb = 0; rows = 128; r0 = 4 * blk; } else { sb = S_P + ((blk - 32) >> 3) * S_S; rows = 32; r0 = 4 * ((blk - 32) & 7); }
    kr0 = rs_of(r0, rows); T = rs_of(r0 + 3, rows) + 8 - kr0; }
  __device__ __forceinline__ int qbase(int p) const { return sb + (r0 + p) * 64; }
  __device__ __forceinline__ int kbase(int t) const { return sb + (kr0 + t) * 64; }
  __device__ __forceinline__ int stride() const { return 1; }
  __device__ __forceinline__ bool first_group() const { return true; }
  __device__ __forceinline__ size_t q2off() const { return 0; }
  __device__ __forceinline__ bool active(int p, int t) const { const int rel = kr0 + t - rs_of(r0 + p, rows); return rel >= 0 && rel <= 7; }
  __device__ __forceinline__ void bias_params(int p, int t, int i, int& tboff, int& lo, int& hi_) const { tboff = (kr0 + t - (r0 + p) + 7) * 31 + 15; int cs = i - 8; cs = cs < 0 ? 0 : (cs > 48 ? 48 : cs); lo = cs - i; hi_ = lo + 15; }
  __device__ __forceinline__ int tb_pre(int x) const { return x < 465 ? x : 464; }
  __device__ __forceinline__ float tb_req(int i) const { return rpb[h * 465 + i]; }
  __device__ __forceinline__ float tb_fin(int, float v) const { return v * LOG2E; }
  __device__ __forceinline__ int live_class(int, int, int odd) const { return odd ? 2 : 1; }
};
struct PolDil {
  static constexpr bool HAS_BIAS = true, HAS_LSE = true, KV_RS = false, KV_PRE = true, Q_PRE = true, Q_PARTS2 = false, MASK_IN_TABLE = true; static constexpr int LVSET = 2; static constexpr int LDQ = NQKV, LDK = NQKV, LDO = DM, NUNITS = 1024, TB_LO = -64, TB_HI = 192;
  const bf16* Q; const bf16* K; const bf16* V; bf16* O; float* lse; const u64* ss; const float* qn; const float* kn; const float* t5; int g, dil;
  int h, sb, rho, nb0, kbfirst, T; bool caseB;
  __device__ __forceinline__ void decode(int u) { h = u & 15; const int chunk = u >> 4; int len, c;
    if (chunk < 32) { sb = 0; len = S_P; c = chunk; } else { sb = S_P + ((chunk - 32) >> 3) * S_S; len = S_S; c = (chunk - 32) & 7; }
    const int nblk = (len / dil) >> 6;
    if (nblk >= 4) { caseB = false; const int per = nblk >> 2; rho = c / per; nb0 = 4 * (c - rho * per); kbfirst = nb0 > 0 ? nb0 - 1 : 0; const int kblast = (nb0 + 4 < nblk) ? nb0 + 4 : nblk - 1; T = kblast - kbfirst + 1; }
    else { caseB = true; rho = 2 * c; nb0 = 0; kbfirst = 0; T = 4; } }
  __device__ __forceinline__ int qbase(int p) const { return caseB ? sb + (p & 1) * 64 * dil + rho + (p >> 1) : sb + (nb0 + p) * 64 * dil + rho; }
  __device__ __forceinline__ int kbase(int t) const { return caseB ? sb + (t & 1) * 64 * dil + rho + (t >> 1) : sb + (kbfirst + t) * 64 * dil + rho; }
  __device__ __forceinline__ int stride() const { return dil; }
  __device__ __forceinline__ bool first_group() const { return g == 0; }
  __device__ __forceinline__ size_t q2off() const { return 0; }
  __device__ __forceinline__ int delta(int p, int t) const { return caseB ? ((t >> 1) - (p >> 1)) * 1024 + (t & 1) - (p & 1) : kbfirst + t - (nb0 + p); }
  __device__ __forceinline__ bool active(int p, int t) const { const int d = delta(p, t); return d >= -1 && d <= 1; }
  __device__ __forceinline__ void bias_params(int p, int t, int i, int& tboff, int& lo, int& hi_) const { const int d = delta(p, t); tboff = 64 + 64 * d; lo = -64 - 64 * d; hi_ = 64 - 64 * d; }
  __device__ __forceinline__ int tb_pre(int x) const { return (int)T5B[g][(x >= 0 && x <= 128) ? x : 0] * 48 + g * 16; }
  __device__ __forceinline__ float tb_req(int i) const { return t5[i + h]; }
  __device__ __forceinline__ float tb_fin(int x, float v) const { return (x >= 0 && x <= 128) ? v * LOG2E : NEGM; }
  __device__ __forceinline__ int live_class(int p, int t, int odd) const { const int d = delta(p, t); return (odd && d == -1) ? 3 : ((!odd && d == 1) ? 4 : 0); }
};
struct PolX {
  static constexpr bool HAS_BIAS = false, HAS_LSE = false, KV_RS = false, KV_PRE = false, Q_PRE = false, Q_PARTS2 = true, MASK_IN_TABLE = false; static constexpr int LVSET = 0; static constexpr int LDQ = 512, LDK = 1024, LDO = 512, NUNITS = 256, TB_LO = 0, TB_HI = 0;
  const bf16* Q; const bf16* K; const bf16* V; bf16* O; float* lse; const u64* ss; const float* qn; const float* kn;
  int h, q0, mb, T;
  __device__ __forceinline__ void decode(int u) { h = u & 3; q0 = (u >> 2) * 256; mb = q0 < S_P ? 0 : 1 + ((q0 - S_P) >> 11); T = 4; }
  __device__ __forceinline__ int qbase(int p) const { return q0 + p * 64; }
  __device__ __forceinline__ int kbase(int t) const { return mb * NMEM + t * 64; }
  __device__ __forceinline__ int stride() const { return 1; }
  __device__ __forceinline__ bool first_group() const { return true; }
  __device__ __forceinline__ size_t q2off() const { return (size_t)(WS_XQ2 - WS_XQ) / 2; }
  __device__ __forceinline__ bool active(int, int) const { return true; }
  __device__ __forceinline__ void bias_params(int, int, int, int& tboff, int& lo, int& hi_) const { tboff = 0; lo = 0; hi_ = 0; }
  __device__ __forceinline__ int tb_pre(int) const { return 0; }
  __device__ __forceinline__ float tb_req(int) const { return 0.f; }
  __device__ __forceinline__ float tb_fin(int, float) const { return 0.f; }
  __device__ __forceinline__ int live_class(int, int, int) const { return 0; }
};

template <class P> __device__ __forceinline__ void attn_phase(P pol, LAS unsigned char* L, int G) {
  int tid_l = threadIdx.x; asm volatile("" : "+v"(tid_l));
  const int tid = tid_l, lane = tid & 63, r32 = lane & 31, hi = lane >> 5; const int wid = __builtin_amdgcn_readfirstlane(tid >> 6);
  const int pr = wid >> 1, qi = 32 * (wid & 1) + r32;
  LAS unsigned char* const Vl = L + A_V; LAS unsigned char* const Kl = L + A_K;
  LAS float* const wsf = (LAS float*)(L + A_WS) + wid * 64; LAS float* const gq = (LAS float*)(L + A_GQ); LAS float* const tb = (LAS float*)(L + A_TB0);
  LAS unsigned char* const ost = L + A_OST + wid * 8192;
  const int sr = tid >> 4, sc = (tid & 15) * 8, vst0 = v_st(sr, sc), vst1 = vst0 + 8192, kst0 = KSWZ(sr, sc * 2), kst1 = kst0 + 8192;
  const int vb0 = (int)(unsigned)(uintptr_t)Vl + v_rd_base(lane);
  int kx[4];
#pragma unroll
  for (int k = 0; k < 4; ++k) kx[k] = KSWZ(r32, (k * 16 + hi * 8) * 2);
  if (!P::Q_PRE && tid < HD) gq[tid] = pol.qn[tid] * pol.kn[tid] * (ATTN_SCALE * LOG2E);
  __syncthreads();
  static_assert(P::TB_HI - P::TB_LO <= NWAVES * 64, "one bias table entry per thread");
  const int tbi = P::HAS_BIAS ? pol.tb_pre(P::TB_LO + tid) : 0; (void)tbi;
  for (int u = blockIdx.x; u < P::NUNITS; u += G) {
    pol.decode(u);
    const int T = pol.T, hoff = pol.h * HD;
    const int qb = __builtin_amdgcn_readfirstlane(pol.qbase(pr)), strd = pol.stride();
    u32x4 ks0, ks1, vs0, vs1; u64 rs0 = 0, rs1 = 0;
    const unsigned so0 = (unsigned)(sr * strd * P::LDK + hoff + sc), so1 = so0 + (unsigned)(32 * strd * P::LDK);
#define SLOAD(t) do { const size_t tb_ = (size_t)__builtin_amdgcn_readfirstlane(pol.kbase(t)) * P::LDK; const bf16* Kt_ = pol.K + tb_; const bf16* Vt_ = pol.V + tb_; \
      ks0 = *(const GAS u32x4*)(Kt_ + so0); ks1 = *(const GAS u32x4*)(Kt_ + so1); vs0 = *(const GAS u32x4*)(Vt_ + so0); vs1 = *(const GAS u32x4*)(Vt_ + so1); \
      if (P::KV_RS) { const u64* sp_ = pol.ss + __builtin_amdgcn_readfirstlane(pol.kbase(t)); rs0 = sp_[sr * strd]; rs1 = sp_[(32 + sr) * strd]; } } while (0)
#define SWRITE(b) do { float e0_ = RMS_EPS, e1_ = RMS_EPS; \
      if (P::KV_RS) { const float v0_ = u64f(rs0) * SS_INV + RMS_EPS, v1_ = u64f(rs1) * SS_INV + RMS_EPS; e0_ = RMS_EPS * v0_; e1_ = RMS_EPS * v1_; \
        vs0 = vscale(vs0, __builtin_amdgcn_rsqf(v0_)); vs1 = vscale(vs1, __builtin_amdgcn_rsqf(v1_)); } \
      *(LAS u32x4*)(Vl + (b) * SHM_V + vst0) = vs0; *(LAS u32x4*)(Vl + (b) * SHM_V + vst1) = vs1; \
      *(LAS u32x4*)(Kl + (b) * SHM_K + kst0) = P::KV_PRE ? ks0 : knorm(ks0, e0_); *(LAS u32x4*)(Kl + (b) * SHM_K + kst1) = P::KV_PRE ? ks1 : knorm(ks1, e1_); } while (0)
    SLOAD(0);
    const float tbv = P::HAS_BIAS ? pol.tb_req(tbi) : 0.f;
    bf16x8 qf[8];
    if (P::Q_PRE) {
      const bf16* Qp = pol.Q + (size_t)qb * P::LDQ + (unsigned)(qi * strd * P::LDQ + hoff + hi * 8);
#pragma unroll
      for (int d0 = 0; d0 < 8; ++d0) qf[d0] = __builtin_bit_cast(bf16x8, *(const GAS u32x4*)(Qp + d0 * 16));
    } else { const bf16* Qp = pol.Q + (size_t)qb * P::LDQ + (unsigned)(qi * strd * P::LDQ + hoff + hi * 8);
      const u64 ssq = pol.ss[qb + qi * strd];
      u32x4 qw[8]; float ss = 0.f;
#pragma unroll
      for (int d0 = 0; d0 < 8; ++d0) qw[d0] = *(const GAS u32x4*)(Qp + d0 * 16);
      if (P::Q_PARTS2) {
#pragma unroll
        for (int d0 = 0; d0 < 8; ++d0) { const u32x4 q2 = *(const GAS u32x4*)(Qp + pol.q2off() + d0 * 16);
#pragma unroll
          for (int e = 0; e < 4; ++e) qw[d0][e] = cvtpk(bflo(qw[d0][e]) + bflo(q2[e]), bfhi(qw[d0][e]) + bfhi(q2[e])); } }
      const float varq = u64f(ssq) * SS_INV + RMS_EPS;
#pragma unroll
      for (int d0 = 0; d0 < 8; ++d0)
#pragma unroll
        for (int e = 0; e < 4; ++e) { const float a = bflo(qw[d0][e]), b = bfhi(qw[d0][e]); ss += a * a + b * b; }
      ss = pl32_sum(ss);
      const float rq = __builtin_amdgcn_rsqf(ss * (1.f / HD) + RMS_EPS * varq);
#pragma unroll
      for (int d0 = 0; d0 < 8; ++d0) { const f32x4 g0 = *(const LAS f32x4*)(gq + d0 * 16 + hi * 8), g1 = *(const LAS f32x4*)(gq + d0 * 16 + hi * 8 + 4); u32x4 w;
        w[0] = cvtpk(bflo(qw[d0][0]) * rq * g0[0], bfhi(qw[d0][0]) * rq * g0[1]); w[1] = cvtpk(bflo(qw[d0][1]) * rq * g0[2], bfhi(qw[d0][1]) * rq * g0[3]);
        w[2] = cvtpk(bflo(qw[d0][2]) * rq * g1[0], bfhi(qw[d0][2]) * rq * g1[1]); w[3] = cvtpk(bflo(qw[d0][3]) * rq * g1[2], bfhi(qw[d0][3]) * rq * g1[3]);
        qf[d0] = __builtin_bit_cast(bf16x8, w); } }
    const LAS unsigned char* const qst = ost + lane * 16;
#pragma unroll
    for (int d0 = 0; d0 < 8; ++d0) *(LAS bf16x8*)(ost + d0 * 1024 + lane * 16) = qf[d0];
    if (P::HAS_BIAS) { const int x = P::TB_LO + tid; if (x < P::TB_HI) tb[x] = pol.tb_fin(x, tbv); }
    SWRITE(0);
    __syncthreads();
    constexpr float m_reg = 0.f; float l_reg = 0.f; f32x16 o[4] = {};
#define PK4(Pv, BASE, OUT) do { unsigned a0 = cvtpk(Pv[BASE + 0], Pv[BASE + 1]), a1 = cvtpk(Pv[BASE + 2], Pv[BASE + 3]);   \
    unsigned b0_ = cvtpk(Pv[BASE + 4], Pv[BASE + 5]), b1_ = cvtpk(Pv[BASE + 6], Pv[BASE + 7]);                              \
    auto r0_ = __builtin_amdgcn_permlane32_swap(a0, b0_, false, false); auto r1_ = __builtin_amdgcn_permlane32_swap(a1, b1_, false, false); \
    u32x4 w_ = {r0_[0], r1_[0], r0_[1], r1_[1]}; OUT = __builtin_bit_cast(bf16x8, w_); } while (0)
#define PIN8(a) asm volatile("" : "+v"(a[0]), "+v"(a[1]), "+v"(a[2]), "+v"(a[3]), "+v"(a[4]), "+v"(a[5]), "+v"(a[6]), "+v"(a[7]))
    for (int t = 0; t < T; ++t) {
      const int b = t & 1;
      if (t + 1 < T) SLOAD(t + 1);
      if (pol.active(pr, t)) {
        auto body = [&](auto lvc) {
          constexpr int LV = decltype(lvc)::value;
          constexpr bool NB0 = LV != 3, NB1 = LV != 4;
          auto live0 = [](int rr) constexpr { return LV == 3 ? false : (LV == 2 ? rr >= 12 : true); };
          auto live1 = [](int rr) constexpr { return LV == 4 ? false : (LV == 1 ? rr < 4 : true); };
          f32x16 p0 = {}, p1 = {};
          int tboff = 0, lo = 0, hi_ = 0; if (P::HAS_BIAS) pol.bias_params(pr, t, qi, tboff, lo, hi_);
          if (P::HAS_BIAS) {
            const LAS unsigned char* tbp = (const LAS unsigned char*)tb + 4 * (tboff + 4 * hi - qi);
#pragma unroll
            for (int rr = 0; rr < 16; ++rr) { const int cj = (rr & 3) + 8 * (rr >> 2); if (live0(rr)) p0[rr] = *(const LAS float*)(tbp + 4 * cj); if (live1(rr)) p1[rr] = *(const LAS float*)(tbp + 4 * (cj + 32)); }
          }
          qkt<NB0, NB1>(p0, p1, Kl + b * SHM_K, qst, kx);
          if (P::HAS_BIAS && !P::MASK_IN_TABLE) {
            const int dbase = 4 * hi - qi - lo; const unsigned width = (unsigned)(hi_ - lo);
#pragma unroll
            for (int rr = 0; rr < 16; ++rr) { const int cj = (rr & 3) + 8 * (rr >> 2);
              if (live0(rr)) p0[rr] = ((unsigned)(dbase + cj) <= width) ? p0[rr] : NEGM; if (live1(rr)) p1[rr] = ((unsigned)(dbase + cj + 32) <= width) ? p1[rr] : NEGM; }
          }
          float ps = 0.f;
#pragma unroll
          for (int r = 0; r < 16; ++r) { if (live0(r)) { p0[r] = __builtin_amdgcn_exp2f(p0[r]); ps += p0[r]; } if (live1(r)) { p1[r] = __builtin_amdgcn_exp2f(p1[r]); ps += p1[r]; } }
          ps = pl32_sum(ps);
          l_reg += ps;
#define PKG(Pv, R0, LIVE) ((LIVE) ? cvtpk(Pv[R0], Pv[(R0) + 1]) : 0u)
#define PK4L(Pv, BASE, LVF, OUT) do { unsigned a0 = PKG(Pv, BASE + 0, LVF(BASE + 0)), a1 = PKG(Pv, BASE + 2, LVF(BASE + 2)), b0_ = PKG(Pv, BASE + 4, LVF(BASE + 4)), b1_ = PKG(Pv, BASE + 6, LVF(BASE + 6)); \
            auto r0_ = __builtin_amdgcn_permlane32_swap(a0, b0_, false, false); auto r1_ = __builtin_amdgcn_permlane32_swap(a1, b1_, false, false); \
            u32x4 w_ = {r0_[0], r1_[0], r0_[1], r1_[1]}; OUT = __builtin_bit_cast(bf16x8, w_); } while (0)
          bf16x8 pa0 = {}, pa1 = {}, pa2 = {}, pa3 = {};
          constexpr int SK = (!live0(0) && !live0(4) ? 1 : 0) | (!live0(8) && !live0(12) ? 2 : 0) | (!live1(0) && !live1(4) ? 4 : 0) | (!live1(8) && !live1(12) ? 8 : 0);
          if (!(SK & 1)) PK4L(p0, 0, live0, pa0); if (!(SK & 2)) PK4L(p0, 8, live0, pa1); if (!(SK & 4)) PK4L(p1, 0, live1, pa2); if (!(SK & 8)) PK4L(p1, 8, live1, pa3);
#undef PK4L
#undef PKG
          SBAR();
          const int vb = vb0 + b * SHM_V;
          pv_one<0, SK>(o[0], vb, pa0, pa1, pa2, pa3); pv_one<1, SK>(o[1], vb, pa0, pa1, pa2, pa3); pv_one<2, SK>(o[2], vb, pa0, pa1, pa2, pa3); pv_one<3, SK>(o[3], vb, pa0, pa1, pa2, pa3);
        };
        const int lvcls = pol.live_class(pr, t, wid & 1);
        if constexpr (P::LVSET == 1) { if (lvcls == 1) body(IC<1>{}); else body(IC<2>{}); }
        else if constexpr (P::LVSET == 2) { if (lvcls == 3) body(IC<3>{}); else if (lvcls == 4) body(IC<4>{}); else body(IC<0>{}); }
        else body(IC<0>{});
      }
      if (t + 1 < T) SWRITE(b ^ 1);
      __syncthreads();
    }
#undef PK4
#undef PIN8
    if (hi == 0) wsf[32 + r32] = l_reg;
    asm volatile("s_waitcnt lgkmcnt(0)" ::: "memory");
#pragma unroll
    for (int r = 0; r < 16; ++r) { const int orow = crow(r, hi); const float rl = __builtin_amdgcn_rcpf(wsf[32 + orow]);
#pragma unroll
      for (int d0 = 0; d0 < 4; ++d0) *(LAS unsigned short*)(ost + (orow * 128 + d0 * 32 + r32) * 2) = (unsigned short)f2bf(o[d0][r] * rl); }
    asm volatile("s_waitcnt lgkmcnt(0)" ::: "memory");
    if (P::HAS_LSE) {
      const bool first = pol.first_group();
      float lse_n = (m_reg + __builtin_amdgcn_logf(l_reg)) * 0.6931471805599453f;
      if (!first) { if (hi == 0) { float* lp = pol.lse + (size_t)(qb + qi * strd) * 16 + pol.h; const float lse_p = *lp; const float Lm = fmaxf(lse_p, lse_n);
          const float wp = __expf(lse_p - Lm), wn = __expf(lse_n - Lm), sm = wp + wn, inv = 1.0f / sm; wsf[r32] = wp * inv; wsf[32 + r32] = wn * inv; *lp = Lm + __logf(sm); }
        asm volatile("s_waitcnt lgkmcnt(0)" ::: "memory"); }
      else { if (hi == 0) pol.lse[(size_t)(qb + qi * strd) * 16 + pol.h] = lse_n; }
#pragma unroll
      for (int it = 0; it < 8; ++it) { const int row = it * 4 + (lane >> 4), ch = lane & 15;
        u32x4 v = *(const LAS u32x4*)(ost + row * 256 + ch * 16);
        bf16* gp = pol.O + (size_t)qb * P::LDO + (unsigned)((32 * (wid & 1) + row) * strd * P::LDO + hoff + ch * 8);
        if (!first) { const u32x4 pv_ = *(const GAS u32x4*)gp; const float wp = wsf[row], wn = wsf[32 + row];
#pragma unroll
          for (int e = 0; e < 4; ++e) v[e] = cvtpk(bflo(pv_[e]) * wp + bflo(v[e]) * wn, bfhi(pv_[e]) * wp + bfhi(v[e]) * wn); }
        *(GAS u32x4*)gp = v; }
    } else {
#pragma unroll
      for (int it = 0; it < 8; ++it) { const int row = it * 4 + (lane >> 4), ch = lane & 15;
        const u32x4 v = *(const LAS u32x4*)(ost + row * 256 + ch * 16);
        *(GAS u32x4*)(pol.O + (size_t)qb * P::LDO + (unsigned)((32 * (wid & 1) + row) * strd * P::LDO + hoff + ch * 8)) = v; }
    }
    asm volatile("s_waitcnt lgkmcnt(0)" ::: "memory");
#undef SLOAD
#undef SWRITE
  }
  __syncthreads();
}
#undef KSWZ
#undef SBAR
}

#ifndef NAIVE_NA
#define NAIVE_NA 0
#endif
#ifndef NAIVE_DIL
#define NAIVE_DIL 0
#endif
#ifndef NAIVE_X
#define NAIVE_X 0
#endif
#ifndef R_PRO
#define R_PRO 1
#endif
#ifndef R_THIN
#define R_THIN 1
#endif
#ifndef R_ATT_NA
#define R_ATT_NA 1
#endif
#ifndef R_ATT_DIL
#define R_ATT_DIL 1
#endif
#ifndef R_ATT_X
#define R_ATT_X 1
#endif
#ifndef R_GQ
#define R_GQ 1
#endif
#ifndef R_GR
#define R_GR 1
#endif
#ifndef R_GU
#define R_GU 1
#endif
#ifndef WGM_QKV
#define WGM_QKV 4
#endif
#ifndef WGM_UP
#define WGM_UP 4
#endif
#ifndef WGM_RES
#define WGM_RES 4
#endif
#ifndef MK_PER_PHASE
#define MK_PER_PHASE 0
#endif
constexpr int NPHASES = 1 + 2 * 8 + 2 * 10;
struct KvOrder {
    int G, c;
    __device__ __forceinline__ bool next(int i, pg8::Unit& u) const { const int L = i * G + c; if (L >= 80) return false; const int l = L / 20, r = L - l * 20; u.pm = l * 5 + (r % 5); u.pn = l * 4 + (r / 5); u.ko = 0; return true; }
    __device__ __forceinline__ void a_ready(const pg8::Unit&) const {}
    __device__ __forceinline__ void done(const pg8::Unit&) const {}
};
struct QxOrder {
    int G, c;
    __device__ __forceinline__ bool next(int i, pg8::Unit& u) const { const int L = i * G + c; if (c < 0 || L >= 256) return false; u.pm = L >> 2; u.pn = (L >> 1) & 1; u.ko = (L & 1) * (DM / 2); return true; }
    __device__ __forceinline__ void a_ready(const pg8::Unit&) const {}
    __device__ __forceinline__ void done(const pg8::Unit&) const {}
};
struct Args { const float* in[25]; float* out; unsigned char* ws; int ph_lo, ph_hi; };
typedef const __attribute__((address_space(4))) Args* kargp;
__global__ void __launch_bounds__(NWAVES * 64, 2) fwd(Args args) {
    extern __shared__ __attribute__((aligned(16))) unsigned char lds[];
    LAS unsigned char* const L = (LAS unsigned char*)lds;
    const int G = gridDim.x;
    { const int t0 = threadIdx.x; for (int u = t0; u < (LDS_BYTES - LDSCTL_OFF) / 4; u += NWAVES * 64) ((LAS unsigned*)(L + LDSCTL_OFF))[u] = 0u; }
    __syncthreads();
    XcdBarrier bar = xcd_barrier_post((unsigned*)(args.ws + WS_CTL) + CW_BAR, (volatile LAS unsigned*)(L + MISC_OFF) + 8);
    const int lo = args.ph_lo, hi = args.ph_hi; int ph = 0;
#define PH_BEGIN if (ph >= lo && ph < hi) { kargp ka = (kargp)__builtin_amdgcn_kernarg_segment_ptr(); asm volatile("" : "+s"(ka)); int tid = threadIdx.x; asm volatile("" : "+v"(tid)); \
        const int lane = tid & 63, wave = __builtin_amdgcn_readfirstlane(tid >> 6), gw = blockIdx.x * NWAVES + wave, NGW = G * NWAVES; (void)lane; (void)gw; (void)NGW; unsigned char* const ws = ka->ws; (void)ws;
#define PH_END   if (ph + 1 < hi) xcd_barrier(bar); } ++ph;
#define WSB(off) ((bf16*)(ws + (off)))

    PH_BEGIN
        LAS float* scr = (LAS float*)(L + RING_OFF + wave * 16384);
        for (int rep_ = 0; rep_ < R_PRO; ++rep_) {
        transpose_tensor(ka->in[8], ka->in[4], 2 * DM, 2, DM, NQKV, WSB(WS_WQKVA), scr, gw, NGW, lane);
        transpose_tensor(ka->in[13], ka->in[4] + DM, 2 * DM, 2, DM, 3 * NQKV, WSB(WS_WQKVB), scr, gw, NGW, lane);
        transpose_tensor(ka->in[12], nullptr, 0, 2, DM, DM, WSB(WS_WOA), scr, gw, NGW, lane);
        transpose_tensor(ka->in[17], nullptr, 0, 2, DM, DM, WSB(WS_WOB), scr, gw, NGW, lane);
        transpose_tensor(ka->in[18], ka->in[5], DM, 4, DM, XHEAD * HD, WSB(WS_WQX), scr, gw, NGW, lane);
        transpose_tensor(ka->in[19], nullptr, 0, 4, DM, 2 * XHEAD * HD, WSB(WS_WKVX), scr, gw, NGW, lane);
        transpose_tensor(ka->in[22], nullptr, 0, 4, XHEAD * HD, DM, WSB(WS_WOX), scr, gw, NGW, lane);
        transpose_tensor(ka->in[23], ka->in[7], DM, 4, DM, DFF, WSB(WS_WUP), scr, gw, NGW, lane);
        transpose_tensor(ka->in[24], nullptr, 0, 4, DFF, DM, WSB(WS_WDN), scr, gw, NGW, lane);
        const float* mem_prompt = ka->in[2]; const float* mem_sample = ka->in[3]; const float* g_mem = ka->in[6]; bf16* MEMN = WSB(WS_OG);
        for (int t = gw; t < 4 * MEMROWS; t += NGW) { const int i = t / MEMROWS, r = t - i * MEMROWS;
            const float* mr = r < NMEM ? mem_prompt + (size_t)r * DM : mem_sample + (size_t)(r - NMEM) * DM;
            rms_row_to_bf16(mr, g_mem + i * DM, MEMN + (size_t)t * DM, lane); }
        { const float* x0 = ka->in[0]; const float* x1 = ka->in[1]; bf16* XB = WSB(WS_H); u64* SS = (u64*)(ws + WS_SS);
          for (int m = gw; m < MTOK; m += NGW) row_to_bf16_ss(m < S_P ? x0 + (size_t)m * DM : x1 + (size_t)(m - S_P) * DM, XB + (size_t)m * DM, SS + m, lane);
          for (int i = blockIdx.x * (NWAVES * 64) + tid; i < 2 * MTOK; i += G * NWAVES * 64) SS[MTOK + i] = 0ull; }
        }
        __syncthreads();
    PH_END
    for (int layer = 0; layer < 4; ++layer) {
        const int li = layer >> 1; const bool odd = (layer & 1) != 0;
        const int ngroups = odd ? 3 : 1;
        for (int step = 0; step <= ngroups; ++step) {
            PH_BEGIN
                if (step > 0) {
                    const int grp = step - 1; bf16* QKV = WSB((grp & 1) ? WS_OG : WS_QKV);
                    if (!odd) {
                        at::PolNA P{}; P.Q = QKV; P.K = QKV + DM; P.V = QKV + 2 * DM; P.O = WSB(WS_O); P.lse = nullptr; P.ss = (const u64*)(ws + WS_SS); P.qn = ka->in[9] + li * HD; P.kn = ka->in[10] + li * HD; P.rpb = ka->in[11] + (size_t)li * 16 * 15 * 31;
                        for (int rep_ = 0; rep_ < R_ATT_NA; ++rep_) at::attn_phase<at::PolNA>(P, L, G);
                    } else { const int dil = grp == 0 ? 1 : (grp == 1 ? 4 : 16);
                        at::PolDil P{}; P.Q = QKV; P.K = QKV + DM; P.V = QKV + 2 * DM; P.O = WSB(WS_O); P.lse = (float*)(ws + WS_LSE);
                        P.ss = (const u64*)(ws + WS_SS); P.qn = ka->in[14] + (li * 3 + grp) * HD; P.kn = ka->in[15] + (li * 3 + grp) * HD; P.t5 = ka->in[16]; P.g = grp; P.dil = dil;
                        for (int rep_ = 0; rep_ < R_ATT_DIL; ++rep_) at::attn_phase<at::PolDil>(P, L, G);
                    }
                }
                if (step < ngroups) {
                    const int grp = step;
                    if (layer > 0 && grp == 0) { u64* SS = (u64*)(ws + WS_SS); for (int i = blockIdx.x * (NWAVES * 64) + tid; i < MTOK; i += G * NWAVES * 64) SS[2 * MTOK + i] = 0ull; }
                    const bf16* Bt = odd ? WSB(WS_WQKVB) + ((size_t)li * 3 + grp) * NQKV * DM : WSB(WS_WQKVA) + (size_t)li * NQKV * DM;
                    int bx_ = (int)blockIdx.x; asm volatile("" : "+s"(bx_));
                    pg8::Gemm g{WSB(WS_H), Bt, MTOK, NQKV, DM}; pg8::StaticOrder S; S.init(MTOK, NQKV, G, bx_, WGM_QKV);
                    LAS float* varl = (LAS float*)(L + LDSCTL_OFF + 1024); LAS float* red = (LAS float*)(L + LDSCTL_OFF + 4096); LAS float* gql = (LAS float*)(L + LDSCTL_OFF + 3072);
                    pg8::Unit u0, u3; const int pm0 = S.next(0, u0) ? u0.pm : -1, pm1 = S.next(3, u3) ? u3.pm : -1;
                    __syncthreads();
                    { const int pmx = tid < 256 ? pm0 : pm1; if (pmx >= 0) varl[tid] = at::u64f(((const u64*)(ws + WS_SS))[pmx * 256 + (tid & 255)]) * SS_INV + RMS_EPS; }
                    if (tid < HD) { const float* qn_ = odd ? ka->in[14] + (li * 3 + grp) * HD : ka->in[9] + li * HD; const float* kn_ = odd ? ka->in[15] + (li * 3 + grp) * HD : ka->in[10] + li * HD;
                        gql[tid] = qn_[tid] * kn_[tid] * (ATTN_SCALE * LOG2E); }
                    __syncthreads();
                    pg8::EpiQKV E{WSB((grp & 1) ? WS_OG : WS_QKV), NQKV, varl, red, pm0, pm1, (const u64*)(ws + WS_SS), gql};
                    for (int rep_ = 0; rep_ < R_GQ; ++rep_) pg8::gemm_phase<pg8::EpiQKV, pg8::StaticOrder, true, true>(L + RING_OFF, g, S, E);
                }
            PH_END
        }
        PH_BEGIN
            float* X = ka->out;
            pg8::Gemm g{WSB(WS_O), (odd ? WSB(WS_WOB) : WSB(WS_WOA)) + (size_t)li * DM * DM, MTOK, DM, DM}; pg8::StaticOrder S; S.init(MTOK, DM, G, (int)blockIdx.x, WGM_RES);
            u64* SS = (u64*)(ws + WS_SS);
            for (int i = blockIdx.x * (NWAVES * 64) + tid; i < MTOK; i += G * NWAVES * 64) SS[i] = 0ull;
            pg8::EpiRes E{WSB(WS_H), nullptr, DM, SS + MTOK, nullptr};
            for (int rep_ = 1; rep_ < R_GR; ++rep_) { pg8::EpiRes E2 = E; E2.outf = (float*)(ws + 960 * MiB); E2.ssout = (u64*)(ws + 8 * MiB); pg8::gemm_phase<pg8::EpiRes, pg8::StaticOrder, true, true>(L + RING_OFF, g, S, E2); }
            pg8::gemm_phase<pg8::EpiRes, pg8::StaticOrder, true, true>(L + RING_OFF, g, S, E);
        PH_END
        PH_BEGIN
            const int nkv = (layer == 0 && G > 160) ? 80 : 0;
            pg8::Gemm g{WSB(WS_H), WSB(WS_WQX) + (size_t)layer * 512 * DM, MTOK, 512, DM / 2, DM}; QxOrder S{G - nkv, (int)blockIdx.x - nkv};
            pg8::EpiBf16<0> E{WSB(WS_XQ), 512, 0, 0, (size_t)(WS_XQ2 - WS_XQ) / 2};
            for (int rep_ = 0; rep_ < R_GU; ++rep_) pg8::gemm_phase<pg8::EpiBf16<0>, QxOrder, true, true>(L + RING_OFF, g, S, E);
            if (layer == 0) {
                pg8::Gemm g2{WSB(WS_OG), WSB(WS_WKVX), 4 * MEMROWS, 4 * 1024, DM}; KvOrder S2{G, (int)blockIdx.x};
                pg8::EpiBf16<0> E2{WSB(WS_KVM), 1024, 1024, 0};
                pg8::gemm_phase<pg8::EpiBf16<0>, KvOrder, true, true>(L + RING_OFF, g2, S2, E2);
            }
        PH_END
        PH_BEGIN
            const bf16* kv = WSB(WS_KVM) + (size_t)layer * MEMROWS * 1024;
#if NAIVE_X
            NaiveX P{WSB(WS_XQ), kv, kv + 512, 1024, ka->in[20] + layer * HD, ka->in[21] + layer * HD, WSB(WS_XO), 512, nullptr, 512};
            attn_naive<NaiveX, 512>(P, gw, NGW, lane);
#else
            at::PolX P{}; P.Q = WSB(WS_XQ); P.K = kv; P.V = kv + 512; P.O = WSB(WS_XO); P.lse = nullptr; P.ss = (const u64*)(ws + WS_SS) + MTOK; P.qn = ka->in[20] + layer * HD; P.kn = ka->in[21] + layer * HD;
            for (int rep_ = 0; rep_ < R_ATT_X; ++rep_) at::attn_phase<at::PolX>(P, L, G);
#endif
        PH_END
        PH_BEGIN
            float* X = ka->out;
            pg8::Gemm g{WSB(WS_XO), WSB(WS_WOX) + (size_t)layer * DM * 512, MTOK, DM, 512}; pg8::StaticOrder S; S.init(MTOK, DM, G, (int)blockIdx.x, WGM_RES);
            u64* SS = (u64*)(ws + WS_SS); pg8::EpiRes E{WSB(WS_H), nullptr, DM, SS + 2 * MTOK, nullptr};
            for (int rep_ = 1; rep_ < R_GR; ++rep_) { pg8::EpiRes E2 = E; E2.outf = (float*)(ws + 960 * MiB); E2.ssout = (u64*)(ws + 8 * MiB); pg8::gemm_phase<pg8::EpiRes, pg8::StaticOrder, true, true>(L + RING_OFF, g, S, E2); }
            pg8::gemm_phase<pg8::EpiRes, pg8::StaticOrder, true, true>(L + RING_OFF, g, S, E);
        PH_END
        PH_BEGIN
            { u64* SS = (u64*)(ws + WS_SS); for (int i = blockIdx.x * (NWAVES * 64) + tid; i < MTOK; i += G * NWAVES * 64) SS[MTOK + i] = 0ull; }
            pg8::Gemm g{WSB(WS_H), WSB(WS_WUP) + (size_t)layer * DFF * DM, MTOK, DFF, DM}; pg8::StaticOrder S; S.init(MTOK, DFF, G, (int)blockIdx.x, WGM_UP);
            pg8::EpiBf16<2> E{WSB(WS_HID), DFF, 0, 0};
            for (int rep_ = 0; rep_ < R_GU; ++rep_) pg8::gemm_phase<pg8::EpiBf16<2>, pg8::StaticOrder, true, true>(L + RING_OFF, g, S, E);
        PH_END
        PH_BEGIN
            float* X = ka->out;
            pg8::Gemm g{WSB(WS_HID), WSB(WS_WDN) + (size_t)layer * DM * DFF, MTOK, DM, DFF}; pg8::StaticOrder S; S.init(MTOK, DM, G, (int)blockIdx.x, WGM_RES);
            u64* SS = (u64*)(ws + WS_SS); pg8::EpiRes E{WSB(WS_H), layer == 3 ? X : nullptr, DM, SS, SS + 2 * MTOK};
            for (int rep_ = 1; rep_ < R_GR; ++rep_) { pg8::EpiRes E2 = E; E2.outf = (float*)(ws + 960 * MiB); E2.ssout = (u64*)(ws + 8 * MiB); pg8::gemm_phase<pg8::EpiRes, pg8::StaticOrder, true, true>(L + RING_OFF, g, S, E2); }
            pg8::gemm_phase<pg8::EpiRes, pg8::StaticOrder, true, true>(L + RING_OFF, g, S, E);
        PH_END
    }
#undef PH_BEGIN
#undef PH_END
#undef WSB
}

extern "C" void kernel_launch(void* const* d_in, const int* in_sizes, int n_in, void* d_out, int out_size, void* d_ws, size_t ws_size, hipStream_t stream) {
    static int grid = 0;
    if (grid == 0) {
        if (n_in != 25 || out_size != MTOK * DM || ws_size < WS_END) { fprintf(stderr, "kernel_launch: unexpected shapes (n_in %d out %d ws %zu need %zu); nothing launched\n", n_in, out_size, ws_size, (size_t)WS_END); grid = -1; return; }
        int dev = 0, cus = 0, per_cu = 0;
        if (hipGetDevice(&dev) != hipSuccess || hipDeviceGetAttribute(&cus, hipDeviceAttributeMultiprocessorCount, dev) != hipSuccess) { grid = -1; return; }
        if (hipFuncSetAttribute((const void*)fwd, hipFuncAttributeMaxDynamicSharedMemorySize, LDS_BYTES) != hipSuccess) { fprintf(stderr, "kernel_launch: hipFuncSetAttribute failed\n"); grid = -1; return; }
        if (hipOccupancyMaxActiveBlocksPerMultiprocessor(&per_cu, (const void*)fwd, NWAVES * 64, LDS_BYTES) != hipSuccess || per_cu < 1) { fprintf(stderr, "kernel_launch: occupancy query says %d blocks per CU\n", per_cu); (void)hipGetLastError(); grid = -1; return; }
        grid = cus;
    }
    if (grid < 0) return;
    (void)hipMemsetAsync((char*)d_ws + WS_CTL, 0, CTL_ZERO_BYTES, stream);
    Args a{};
    for (int i = 0; i < 25; ++i) a.in[i] = (const float*)d_in[i];
    a.out = (float*)d_out; a.ws = (unsigned char*)d_ws;
#if MK_PER_PHASE
    for (int p = 0; p < NPHASES; ++p) { a.ph_lo = p; a.ph_hi = p + 1; hipLaunchKernelGGL(fwd, dim3(grid), dim3(NWAVES * 64), LDS_BYTES, stream, a); }
#else
    a.ph_lo = 0; a.ph_hi = NPHASES;
    hipLaunchKernelGGL(fwd, dim3(grid), dim3(NWAVES * 64), LDS_BYTES, stream, a);
#endif
    const hipError_t le = hipPeekAtLastError();
    if (le != hipSuccess) fprintf(stderr, "kernel_launch: launch failed: %s\n", hipGetErrorName(le));
}
```

```cpp
#include <hip/hip_runtime.h>
#include <cstdio>
#include <cstdint>
namespace pg8 {
#define PG8_LAS __attribute__((address_space(3)))
typedef unsigned short bf16_t;
typedef short bf16x8 __attribute__((ext_vector_type(8)));
typedef float f32x4 __attribute__((ext_vector_type(4)));
typedef unsigned u32x4 __attribute__((ext_vector_type(4)));
constexpr int BM = 256, BK = 64, HALF = 128, HTB = HALF * BK * 2  , STAGE_BYTES = 8 * HTB, NXCD = 8, WGM = 4;

__host__ __device__ __forceinline__ int lds_byte(int r, int c) { const int st = (r >> 4) * 2 + (c >> 5), rr = r & 15, cc = c & 31, ob = rr * 64 + cc * 2; return st * 1024 + (ob ^ (((ob >> 9) & 1) << 5)); }
__host__ __device__ __forceinline__ void stage_rc(int b, int& R, int& C) { const int st = b / 1024, sb = b % 1024, swz = sb ^ (((sb >> 9) & 1) << 5); R = (st >> 1) * 16 + swz / 64; C = (st & 1) * 32 + (swz % 64) / 2; }
__host__ __device__ __forceinline__ int perm32(int rho) { const int n = rho >> 4, i = rho & 15; return 8 * (i >> 2) + 4 * n + (i & 3); }

struct Unit { int pm, pn, ko; };
struct Gemm { const bf16_t* A; const bf16_t* Bt; int M, N, K, ld; };

struct StaticOrder {
    int nM, nN, nwg, G, c, wgm;
    __host__ __device__ void init(int M, int N, int G_, int c_, int wgm_ = WGM) { nM = M / BM; nN = N / BM; nwg = nM * nN; G = G_; c = c_; wgm = wgm_; }
    __host__ __device__ bool next(int i, Unit& u) const {
        const long L = (long)i * G + c; if (L >= nwg) return false;
        int wgid = (int)L; { const int q = nwg / NXCD, r = nwg % NXCD, xcd = wgid % NXCD, off = wgid / NXCD; wgid = (xcd < r ? xcd * (q + 1) : r * (q + 1) + (xcd - r) * q) + off; }
        const int nig = wgm * nN, gid = wgid / nig, fm = gid * wgm, gsz = (nM - fm) < wgm ? (nM - fm) : wgm;
        u.pm = fm + ((wgid % nig) % gsz); u.pn = (wgid % nig) / gsz; u.ko = 0; return true;
    }
    __device__ __forceinline__ void a_ready(const Unit&) const {}
    __device__ __forceinline__ void done(const Unit&) const {}
};

__device__ __forceinline__ unsigned cvt_pk_bf16(float lo, float hi) { unsigned r; asm volatile("v_cvt_pk_bf16_f32 %0, %1, %2" : "=v"(r) : "v"(lo), "v"(hi)); return r; }
typedef float f32x2 __attribute__((ext_vector_type(2)));
typedef unsigned u32x2 __attribute__((ext_vector_type(2)));
template <int ACT> struct EpiBf16 {
    static constexpr bool PERM = true, AFTER_DRAIN = false; static_assert(ACT == 0 || ACT == 2, "EpiBf16: ACT is 0 (none) or 2 (squared relu)");
    bf16_t* O; int ldc; int split_cols; size_t split_stride; size_t ko_stride;
    __device__ __forceinline__ void operator()(const f32x4 (&acc)[2][2][4][2], const Unit& u, int wr, int wc, int fr, int fq) const {
        const int row0 = u.pm * BM + wr * 64 + fr; int colt = u.pn * BM; bf16_t* base = O;
        if (split_cols) { const int t = colt / split_cols; base += (size_t)t * split_stride; colt -= t * split_cols; }
        if (u.ko) base += ko_stride;
        const int col0 = colt + wc * 32 + 8 * fq;
#pragma unroll
        for (int ai = 0; ai < 2; ++ai)
#pragma unroll
            for (int m = 0; m < 4; ++m) { bf16_t* rowp = base + (size_t)(row0 + ai * HALF + m * 16) * ldc + col0;
#pragma unroll
                for (int bj = 0; bj < 2; ++bj) { f32x4 v0 = acc[ai][bj][m][0], v1 = acc[ai][bj][m][1];
                    if (ACT == 2) {
#pragma unroll
                        for (int e = 0; e < 4; ++e) { const float a = fmaxf(v0[e], 0.f), b = fmaxf(v1[e], 0.f); v0[e] = a * a; v1[e] = b * b; } }
                    u32x4 w; w.x = cvt_pk_bf16(v0[0], v0[1]); w.y = cvt_pk_bf16(v0[2], v0[3]); w.z = cvt_pk_bf16(v1[0], v1[1]); w.w = cvt_pk_bf16(v1[2], v1[3]);
                    *(u32x4*)(rowp + bj * HALF) = w; } }
    }
};
struct EpiRes {
    static constexpr bool PERM = true, AFTER_DRAIN = false;
    bf16_t* xb; float* outf; int ldc; unsigned long long* ssout; const unsigned long long* ssin;
    __device__ __forceinline__ void operator()(const f32x4 (&acc)[2][2][4][2], const Unit& u, int wr, int wc, int fr, int fq) const {
        const int row0 = u.pm * BM + wr * 64 + fr, col0 = u.pn * BM + wc * 32 + 8 * fq;
        float sq[2][4];
#pragma unroll
        for (int ai = 0; ai < 2; ++ai) {
            u32x4 b[4][2]; unsigned long long sv[4];
#pragma unroll
            for (int m = 0; m < 4; ++m) { const bf16_t* bp = xb + (size_t)(row0 + ai * HALF + m * 16) * ldc + col0;
#pragma unroll
                for (int bj = 0; bj < 2; ++bj) b[m][bj] = *(const u32x4*)(bp + bj * HALF);
                sv[m] = ssin ? ssin[row0 + ai * HALF + m * 16] : 0ull; }
#pragma unroll
            for (int m = 0; m < 4; ++m) { const int row = row0 + ai * HALF + m * 16; bf16_t* xp = xb + (size_t)row * ldc + col0;
                const float sc = ssin ? 1.0f / ((float)sv[m] * (1.f / (16777216.f * 2048.f)) + 1e-6f) : 1.f;
                float q = 0.f;
#pragma unroll
                for (int bj = 0; bj < 2; ++bj) { f32x4 v0, v1;
#pragma unroll
                    for (int e = 0; e < 2; ++e) { v0[2 * e] = __builtin_bit_cast(float, b[m][bj][e] << 16); v0[2 * e + 1] = __builtin_bit_cast(float, b[m][bj][e] & 0xffff0000u);
                                                  v1[2 * e] = __builtin_bit_cast(float, b[m][bj][2 + e] << 16); v1[2 * e + 1] = __builtin_bit_cast(float, b[m][bj][2 + e] & 0xffff0000u); }
                    v0 += acc[ai][bj][m][0] * sc; v1 += acc[ai][bj][m][1] * sc;
                    q += ((v0[0] * v0[0] + v0[1] * v0[1]) + (v0[2] * v0[2] + v0[3] * v0[3])) + ((v1[0] * v1[0] + v1[1] * v1[1]) + (v1[2] * v1[2] + v1[3] * v1[3]));
                    if (outf) { float* op = outf + (size_t)row * ldc + col0 + bj * HALF; *(f32x4*)op = v0; *(f32x4*)(op + 4) = v1; }
                    else { u32x4 w; w.x = cvt_pk_bf16(v0[0], v0[1]); w.y = cvt_pk_bf16(v0[2], v0[3]); w.z = cvt_pk_bf16(v1[0], v1[1]); w.w = cvt_pk_bf16(v1[2], v1[3]); *(u32x4*)(xp + bj * HALF) = w; } }
                sq[ai][m] = q; }
            asm volatile("" ::: "memory");
        }
#pragma unroll
        for (int ai = 0; ai < 2; ++ai) {
#pragma unroll
            for (int m = 0; m < 4; ++m) { float q = sq[ai][m]; q += __shfl_xor(q, 16); q += __shfl_xor(q, 32); sq[ai][m] = q; }
            const float v = fq == 0 ? sq[ai][0] : (fq == 1 ? sq[ai][1] : (fq == 2 ? sq[ai][2] : sq[ai][3]));
            atomicAdd(ssout + (u.pm * BM + wr * 64 + ai * HALF + fq * 16 + fr), (unsigned long long)(v * 16777216.f)); }
    }
};

struct EpiQKV {
    static constexpr bool PERM = true, AFTER_DRAIN = false; static constexpr int NS = 16;
    bf16_t* O; int ldc; const PG8_LAS float* varl; PG8_LAS float* red; int pm0, pm1; const unsigned long long* ss; const PG8_LAS float* gql;
    __device__ __forceinline__ void operator()(const f32x4 (&acc)[2][2][4][2], const Unit& u, int wr, int wc, int fr, int fq) const {
        const int row0 = u.pm * BM + wr * 64 + fr, col0 = u.pn * BM + wc * 32 + 8 * fq;
        const int kind = u.pn >> 3;
        float sc[2][2][4];
#pragma unroll
        for (int ai = 0; ai < 2; ++ai)
#pragma unroll
            for (int bj = 0; bj < 2; ++bj)
#pragma unroll
                for (int m = 0; m < 4; ++m) sc[ai][bj][m] = 1.f;
        {
            float var[2][4];
            const int slot = u.pm == pm0 ? 0 : (u.pm == pm1 ? 1 : -1);
#pragma unroll
            for (int ai = 0; ai < 2; ++ai)
#pragma unroll
                for (int m = 0; m < 4; ++m) { const int rl = ai * HALF + wr * 64 + m * 16 + fr;
                    var[ai][m] = slot >= 0 ? varl[slot * BM + rl] : (float)ss[u.pm * BM + rl] * (1.f / (16777216.f * 2048.f)) + 1e-6f; }
            if (kind != 2) {
#pragma unroll
                for (int ai = 0; ai < 2; ++ai)
#pragma unroll
                    for (int bj = 0; bj < 2; ++bj)
#pragma unroll
                        for (int m = 0; m < 4; ++m) { const f32x4 a = acc[ai][bj][m][0], b = acc[ai][bj][m][1];
                            float q = ((a[0] * a[0] + a[1] * a[1]) + (a[2] * a[2] + a[3] * a[3])) + ((b[0] * b[0] + b[1] * b[1]) + (b[2] * b[2] + b[3] * b[3]));
                            q += __shfl_xor(q, 16); q += __shfl_xor(q, 32);
                            if (fq == 0) red[((ai * HALF + wr * 64 + m * 16 + fr) * 2 + bj) * 4 + wc] = q; }
                asm volatile("s_waitcnt lgkmcnt(0)" ::: "memory");
                __builtin_amdgcn_s_barrier();
#pragma unroll
                for (int ai = 0; ai < 2; ++ai)
#pragma unroll
                    for (int bj = 0; bj < 2; ++bj)
#pragma unroll
                        for (int m = 0; m < 4; ++m) { const f32x4 r4 = *(const PG8_LAS f32x4*)(red + ((ai * HALF + wr * 64 + m * 16 + fr) * 2 + bj) * 4);
                            sc[ai][bj][m] = __builtin_amdgcn_rsqf(((r4[0] + r4[1]) + (r4[2] + r4[3])) * (1.f / 128.f) + 1e-6f * var[ai][m]); }
            } else {
#pragma unroll
                for (int ai = 0; ai < 2; ++ai)
#pragma unroll
                    for (int m = 0; m < 4; ++m) { const float r = __builtin_amdgcn_rsqf(var[ai][m]); sc[ai][0][m] = r; sc[ai][1][m] = r; }
            }
        }
        if (kind == 0) {
            const f32x4 g0 = *(const PG8_LAS f32x4*)(gql + wc * 32 + 8 * fq), g1 = *(const PG8_LAS f32x4*)(gql + wc * 32 + 8 * fq + 4);
#pragma unroll
            for (int ai = 0; ai < 2; ++ai)
#pragma unroll
                for (int m = 0; m < 4; ++m) { bf16_t* rowp = O + (size_t)(row0 + ai * HALF + m * 16) * ldc + col0;
#pragma unroll
                    for (int bj = 0; bj < 2; ++bj) { const f32x4 v0 = acc[ai][bj][m][0] * sc[ai][bj][m] * g0, v1 = acc[ai][bj][m][1] * sc[ai][bj][m] * g1;
                        u32x4 w; w.x = cvt_pk_bf16(v0[0], v0[1]); w.y = cvt_pk_bf16(v0[2], v0[3]); w.z = cvt_pk_bf16(v1[0], v1[1]); w.w = cvt_pk_bf16(v1[2], v1[3]);
                        *(u32x4*)(rowp + bj * HALF) = w; } }
        } else {
#pragma unroll
            for (int ai = 0; ai < 2; ++ai)
#pragma unroll
                for (int m = 0; m < 4; ++m) { bf16_t* rowp = O + (size_t)(row0 + ai * HALF + m * 16) * ldc + col0;
#pragma unroll
                    for (int bj = 0; bj < 2; ++bj) { const f32x4 v0 = acc[ai][bj][m][0] * sc[ai][bj][m], v1 = acc[ai][bj][m][1] * sc[ai][bj][m];
                        u32x4 w; w.x = cvt_pk_bf16(v0[0], v0[1]); w.y = cvt_pk_bf16(v0[2], v0[3]); w.z = cvt_pk_bf16(v1[0], v1[1]); w.w = cvt_pk_bf16(v1[2], v1[3]);
                        *(u32x4*)(rowp + bj * HALF) = w; } }
        }
    }
};
template <class Epi, class Sched, bool ALIGN_EPI = false, bool SP2 = false>
__device__ __forceinline__ void gemm_phase(PG8_LAS unsigned char* lds, const Gemm g, const Sched& S, const Epi& E) {
    int tid_l = threadIdx.x; asm volatile("" : "+v"(tid_l));
    const int tid = tid_l, wid = __builtin_amdgcn_readfirstlane(tid >> 6), lane = tid & 63, wr = wid >> 2, wc = wid & 3, fr = lane & 15, fq = lane >> 4;
    const int K = g.K, nt = K / BK, LD = g.ld ? g.ld : g.K;
    unsigned voffA[2], voffB[2];
#pragma unroll
    for (int i = 0; i < 2; ++i) { int R, C; stage_rc(tid * 16 + i * 8192, R, C); const int Rb = Epi::PERM ? ((R & ~31) + perm32(R & 31)) : R;
        voffA[i] = (unsigned)(R * LD + C) * 2u; voffB[i] = (unsigned)(Rb * LD + C) * 2u; }
    const size_t kstep = (size_t)(BK * 2);
    const size_t hstep = (size_t)HALF * LD * 2;
    const size_t tstep = 2 * hstep;
    const unsigned ldsw = (unsigned)wid * 1024u;
    const int aoff = lds_byte(wr * 64 + fr, fq * 8), boff = lds_byte(wc * 32 + fr, fq * 8);
#define PG8_SA(b, h) (((b) * 2 + (h)) * HTB)
#define PG8_SB(b, h) ((4 + (b) * 2 + (h)) * HTB)
#define PG8_STAGE(bufoff, gbase, voff) do { _Pragma("unroll") for (int _i = 0; _i < 2; ++_i) \
        __builtin_amdgcn_global_load_lds((const unsigned*)((const char*)(gbase) + (voff)[_i]), (PG8_LAS unsigned*)(lds + (bufoff) + ldsw + _i * 8192), 16, 0, 0); } while (0)
#define PG8_LDA(dst, b, h) do { _Pragma("unroll") for (int m = 0; m < 4; ++m) _Pragma("unroll") for (int k = 0; k < 2; ++k) dst[m][k] = *(const PG8_LAS bf16x8*)(lds + PG8_SA(b, h) + aoff + m * 2048 + k * 1024); } while (0)
#define PG8_LDB(dst, b, h) do { _Pragma("unroll") for (int n = 0; n < 2; ++n) _Pragma("unroll") for (int k = 0; k < 2; ++k) dst[n][k] = *(const PG8_LAS bf16x8*)(lds + PG8_SB(b, h) + boff + n * 2048 + k * 1024); } while (0)
#define PG8_MMA(ai, bj, At, Bt) do { __builtin_amdgcn_s_setprio(1); _Pragma("unroll") for (int m = 0; m < 4; ++m) _Pragma("unroll") for (int n = 0; n < 2; ++n) _Pragma("unroll") for (int k = 0; k < 2; ++k) \
        acc[ai][bj][m][n] = __builtin_amdgcn_mfma_f32_16x16x32_bf16(Bt[n][k], At[m][k], acc[ai][bj][m][n], 0, 0, 0); __builtin_amdgcn_s_setprio(0); } while (0)
#define PG8_WAIT_V(n) asm volatile("s_waitcnt vmcnt(" #n ")" ::: "memory")
#define PG8_WAIT_L(n) asm volatile("s_waitcnt lgkmcnt(" #n ")" ::: "memory")
#define PG8_BAR __builtin_amdgcn_s_barrier()
#define PG8_SCHED __builtin_amdgcn_sched_barrier(0)
    Unit cur, nxt; int ui = 0;
    if (!S.next(0, cur)) return;
    f32x4 acc[2][2][4][2];
#pragma unroll
    for (int a = 0; a < 2; ++a)
#pragma unroll
        for (int b = 0; b < 2; ++b)
#pragma unroll
            for (int m = 0; m < 4; ++m)
#pragma unroll
                for (int n = 0; n < 2; ++n) acc[a][b][m][n] = (f32x4){0.f, 0.f, 0.f, 0.f};
    bf16x8 At[4][2], B0[2][2], B1[2][2];
    const char* cA = (const char*)g.A + (size_t)cur.pm * tstep + (size_t)cur.ko * 2; const char* cB = (const char*)g.Bt + (size_t)cur.pn * tstep + (size_t)cur.ko * 2;
    S.a_ready(cur);
    if constexpr (SP2) {
        PG8_STAGE(PG8_SB(0, 0), cB, voffB); PG8_STAGE(PG8_SB(0, 1), cB + hstep, voffB); PG8_STAGE(PG8_SA(0, 0), cA, voffA); PG8_STAGE(PG8_SA(0, 1), cA + hstep, voffA);
        if (wr == 1) PG8_BAR;
        PG8_WAIT_V(2); PG8_BAR;
        PG8_STAGE(PG8_SB(1, 0), cB + kstep, voffB); PG8_STAGE(PG8_SA(1, 0), cA + kstep, voffA); PG8_STAGE(PG8_SB(1, 1), cB + hstep + kstep, voffB);
        PG8_WAIT_V(6); PG8_BAR;
    } else {
        PG8_STAGE(PG8_SB(0, 0), cB, voffB); PG8_STAGE(PG8_SA(0, 0), cA, voffA); PG8_STAGE(PG8_SB(0, 1), cB + hstep, voffB); PG8_STAGE(PG8_SA(0, 1), cA + hstep, voffA);
        if (wr == 1) PG8_BAR;
        PG8_WAIT_V(4); PG8_BAR;
        PG8_STAGE(PG8_SB(1, 0), cB + kstep, voffB); PG8_STAGE(PG8_SA(1, 0), cA + kstep, voffA); PG8_STAGE(PG8_SB(1, 1), cB + hstep + kstep, voffB);
        PG8_WAIT_V(6); PG8_BAR;
    }
    for (;;) {
        const bool has_next = S.next(ui + 1, nxt);
        const char* nA = has_next ? (const char*)g.A + (size_t)nxt.pm * tstep + (size_t)nxt.ko * 2 : cA; const char* nB = has_next ? (const char*)g.Bt + (size_t)nxt.pn * tstep + (size_t)nxt.ko * 2 : cB;
        for (int t = 0; t < nt; t += 2) {
            const bool last = (t == nt - 2);
            const char* a1 = cA + (size_t)(t + 1) * kstep;
            const char* a2 = last ? nA : cA + (size_t)(t + 2) * kstep; const char* b2 = last ? nB : cB + (size_t)(t + 2) * kstep;
            const char* a3 = a2 + kstep; const char* b3 = b2 + kstep;
            if (last && has_next) S.a_ready(nxt);
            if constexpr (SP2) {
            PG8_LDB(B0, 0, 0); PG8_LDB(B1, 0, 1); PG8_SCHED; PG8_LDA(At, 0, 0); PG8_STAGE(PG8_SA(1, 1), a1 + hstep, voffA);
            PG8_WAIT_V(8); PG8_WAIT_L(0); PG8_BAR; PG8_MMA(0, 0, At, B0); PG8_MMA(0, 1, At, B1); PG8_BAR; PG8_SCHED;
            PG8_LDA(At, 0, 1); PG8_STAGE(PG8_SB(0, 0), b2, voffB); PG8_STAGE(PG8_SB(0, 1), b2 + hstep, voffB); PG8_STAGE(PG8_SA(0, 0), a2, voffA);
            PG8_WAIT_V(8); PG8_WAIT_L(0); PG8_BAR; PG8_MMA(1, 0, At, B0); PG8_MMA(1, 1, At, B1); PG8_BAR; PG8_SCHED;
            PG8_LDB(B0, 1, 0); PG8_LDB(B1, 1, 1); PG8_SCHED; PG8_LDA(At, 1, 0); PG8_STAGE(PG8_SA(0, 1), a2 + hstep, voffA);
            PG8_WAIT_V(8); PG8_WAIT_L(0); PG8_BAR; PG8_MMA(0, 0, At, B0); PG8_MMA(0, 1, At, B1); PG8_BAR; PG8_SCHED;
            PG8_LDA(At, 1, 1); PG8_STAGE(PG8_SB(1, 0), b3, voffB); PG8_STAGE(PG8_SB(1, 1), b3 + hstep, voffB); PG8_STAGE(PG8_SA(1, 0), a3, voffA);
            PG8_WAIT_V(8); PG8_WAIT_L(0); PG8_BAR; PG8_MMA(1, 0, At, B0); PG8_MMA(1, 1, At, B1); PG8_BAR; PG8_SCHED;
            } else {
            PG8_LDB(B0, 0, 0); PG8_SCHED; PG8_LDA(At, 0, 0); PG8_STAGE(PG8_SA(1, 1), a1 + hstep, voffA);
            PG8_WAIT_L(8); PG8_BAR; PG8_WAIT_L(0); PG8_MMA(0, 0, At, B0); PG8_BAR; PG8_SCHED;
            PG8_LDB(B1, 0, 1); PG8_STAGE(PG8_SB(0, 0), b2, voffB);
            PG8_BAR; PG8_WAIT_L(0); PG8_MMA(0, 1, At, B1); PG8_BAR;
            PG8_LDA(At, 0, 1); PG8_STAGE(PG8_SA(0, 0), a2, voffA);
            PG8_BAR; PG8_WAIT_L(0); PG8_MMA(1, 0, At, B0); PG8_BAR; PG8_SCHED;
            PG8_STAGE(PG8_SB(0, 1), b2 + hstep, voffB);
            PG8_WAIT_V(6); PG8_BAR; PG8_MMA(1, 1, At, B1); PG8_BAR;
            PG8_LDB(B0, 1, 0); PG8_SCHED; PG8_LDA(At, 1, 0); PG8_STAGE(PG8_SA(0, 1), a2 + hstep, voffA);
            PG8_WAIT_L(8); PG8_BAR; PG8_WAIT_L(0); PG8_MMA(0, 0, At, B0); PG8_BAR; PG8_SCHED;
            PG8_LDB(B1, 1, 1); PG8_STAGE(PG8_SB(1, 0), b3, voffB);
            PG8_BAR; PG8_WAIT_L(0); PG8_MMA(0, 1, At, B1); PG8_BAR;
            PG8_LDA(At, 1, 1); PG8_STAGE(PG8_SA(1, 0), a3, voffA);
            PG8_BAR; PG8_WAIT_L(0); PG8_MMA(1, 0, At, B0); PG8_BAR; PG8_SCHED;
            PG8_STAGE(PG8_SB(1, 1), b3 + hstep, voffB);
            PG8_WAIT_V(6); PG8_BAR; PG8_MMA(1, 1, At, B1); PG8_BAR;
            }
        }
        if constexpr (ALIGN_EPI) { if (wr == 0) PG8_BAR; }
        if constexpr (!Epi::AFTER_DRAIN) { E(acc, cur, wr, wc, fr, fq); S.done(cur); }
        if (!has_next) break;
#pragma unroll
        for (int a = 0; a < 2; ++a)
#pragma unroll
            for (int b = 0; b < 2; ++b)
#pragma unroll
                for (int m = 0; m < 4; ++m)
#pragma unroll
                    for (int n = 0; n < 2; ++n) acc[a][b][m][n] = (f32x4){0.f, 0.f, 0.f, 0.f};
        cur = nxt; cA = nA; cB = nB; ++ui;
        if constexpr (ALIGN_EPI) { if (wr == 1) PG8_BAR; }
    }
    PG8_WAIT_V(0);
    if constexpr (!ALIGN_EPI) { if (wr == 0) PG8_BAR; }
    PG8_BAR;
    if constexpr (Epi::AFTER_DRAIN) { E.fused(acc, cur, wr, wc, fr, fq, lds, wid, lane); S.done(cur); }
#undef PG8_SA
#undef PG8_SB
#undef PG8_STAGE
#undef PG8_LDA
#undef PG8_LDB
#undef PG8_MMA
#undef PG8_WAIT_V
#undef PG8_WAIT_L
#undef PG8_BAR
#undef PG8_SCHED
}
}
constexpr int NWAVES = 8;
constexpr int DM = 2048, MTOK = 16384, DFF = 8192, HD = 128, NHEAD = 16, XHEAD = 4, NMEM = 256;
constexpr int S_P = 8192, S_S = 2048;
constexpr int MEMROWS = 5 * NMEM;
constexpr int NQKV = 3 * DM;
constexpr float RMS_EPS = 1e-6f;
constexpr float ATTN_SCALE = 0.08838834764831845f;
constexpr float LOG2E = 1.4426950408889634f;

constexpr size_t MiB = 1u << 20;
constexpr size_t WS_CTL = 0, CTL_ZERO_BYTES = 1 * MiB;
constexpr size_t WS_LSE = 1 * MiB;
constexpr size_t WS_SS = 4 * MiB;
typedef unsigned long long u64;
constexpr float SS_SCALE = 16777216.f, SS_INV = 1.f / (16777216.f * 2048.f);
constexpr size_t WS_WQKVA = 16 * MiB;
constexpr size_t WS_WQKVB = 64 * MiB;
constexpr size_t WS_WOA = 208 * MiB, WS_WOB = 224 * MiB;
constexpr size_t WS_WQX = 240 * MiB;
constexpr size_t WS_WKVX = 248 * MiB;
constexpr size_t WS_WOX = 264 * MiB;
constexpr size_t WS_WUP = 272 * MiB;
constexpr size_t WS_WDN = 400 * MiB;
constexpr size_t WS_H = 528 * MiB;
constexpr size_t WS_O = 592 * MiB;
constexpr size_t WS_XQ = 656 * MiB, WS_XO = 672 * MiB;
constexpr size_t WS_KVM = 688 * MiB;
constexpr size_t WS_QKV = 704 * MiB;
constexpr size_t WS_OG = 896 * MiB;
constexpr size_t WS_HID = 704 * MiB;
constexpr size_t WS_XQ2 = 1088 * MiB;
constexpr size_t WS_END = 1104 * MiB;
constexpr int CW_BAR = 4096;

constexpr int RING_OFF = 0, RING_BYTES = 131072;
constexpr int LDSCTL_OFF = RING_BYTES, MISC_OFF = LDSCTL_OFF + 320;
constexpr int LDS_BYTES = 147456;

#define GAS __attribute__((address_space(1)))
#define LAS __attribute__((address_space(3)))
typedef unsigned short bf16;
typedef unsigned v4u __attribute__((ext_vector_type(4)));
typedef unsigned v2u __attribute__((ext_vector_type(2)));
typedef float f32x4 __attribute__((ext_vector_type(4)));
typedef GAS unsigned gu32;
#define LDS_WAIT() asm volatile("s_waitcnt lgkmcnt(0)" ::: "memory")
#define VM_WAIT() asm volatile("s_waitcnt vmcnt(0)" ::: "memory")
__device__ __forceinline__ unsigned f2bf(float f) { unsigned u = __builtin_bit_cast(unsigned, f); return (u + 0x7fffu + ((u >> 16) & 1u)) >> 16; }
__device__ __forceinline__ unsigned pk2(float lo, float hi) { return f2bf(lo) | (f2bf(hi) << 16); }
__device__ __forceinline__ float bflo(unsigned w) { return __builtin_bit_cast(float, w << 16); }
__device__ __forceinline__ float bfhi(unsigned w) { return __builtin_bit_cast(float, w & 0xffff0000u); }
__device__ __forceinline__ float wave_sum(float v) {
#pragma unroll
    for (int o = 1; o < 64; o <<= 1) v += __shfl_xor(v, o);
    return v;
}
__device__ __forceinline__ float wave_max(float v) {
#pragma unroll
    for (int o = 1; o < 64; o <<= 1) v = fmaxf(v, __shfl_xor(v, o));
    return v;
}
__device__ __forceinline__ void seq_of(int m, int& sb, int& len) { if (m < S_P) { sb = 0; len = S_P; } else { sb = S_P + ((m - S_P) & ~(S_S - 1)); len = S_S; } }

#define XB_TMO      128
#define XB_XCNT(j)  (256  + 64 * (j))
#define XB_XSUB(j)  (1280 + 64 * (j))
#define XB_XGEN(j)  (2304 + 64 * (j))
#define XB_TOP      3328
#define XB_TOPGEN   3392
#define XCD_BAR_WORDS 3456
#define XB_SPIN_CAP (1u << 18)

__device__ __forceinline__ unsigned xb_ld(unsigned* p)              { return __hip_atomic_load(p, __ATOMIC_RELAXED, __HIP_MEMORY_SCOPE_AGENT); }
__device__ __forceinline__ unsigned xb_add(unsigned* p, unsigned v) { return __hip_atomic_fetch_add(p, v, __ATOMIC_RELAXED, __HIP_MEMORY_SCOPE_AGENT); }
__device__ __forceinline__ unsigned xb_xcc_id() { return (unsigned)__builtin_amdgcn_s_getreg((3 << 11) | 20) & 0xFu; }
#define XB_SPIN(cond, bar) do { unsigned _sp = 0; while (cond) { __builtin_amdgcn_s_sleep(1); \
    if ((++_sp & 255u) == 0u) { if (xb_ld(&(bar)[XB_TMO])) break; if (_sp > XB_SPIN_CAP) { atomicAdd(&(bar)[XB_TMO], 1u); break; } } } } while (0)

struct XcdBarrier {
    unsigned* bar; unsigned x;
    volatile LAS unsigned* st;
};

__device__ __forceinline__ XcdBarrier xcd_barrier_post(unsigned* bar, volatile LAS unsigned* st) {
    XcdBarrier b; b.bar = bar; b.x = xb_xcc_id(); b.st = st;
    if (threadIdx.x == 0) (void)xb_add(&bar[XB_XCNT(b.x)], 1u);
    return b;
}
__device__ __forceinline__ void xcd_barrier_complete(unsigned* bar, unsigned x, unsigned& nloc, unsigned& nx) {
    const unsigned G = gridDim.x * gridDim.y * gridDim.z;
    unsigned sum, cnt, mine, sp = 0u;
    for (;;) {
        sum = 0u; cnt = 0u; mine = 0u;
#pragma unroll
        for (unsigned j = 0; j < 16; ++j) { const unsigned c = xb_ld(&bar[XB_XCNT(j)]); sum += c; cnt += (c > 0u) ? 1u : 0u; mine = (j == x) ? c : mine; }
        if (sum == G) break;
        __builtin_amdgcn_s_sleep(1);
        if ((++sp & 255u) == 0u) { if (xb_ld(&bar[XB_TMO])) break; if (sp > XB_SPIN_CAP) { atomicAdd(&bar[XB_TMO], 1u); break; } }
    }
    nloc = mine > 0u ? mine : 1u; nx = cnt > 0u ? cnt : 1u;
}

__device__ __forceinline__ void xcd_barrier(const XcdBarrier& b) {
    asm volatile("s_waitcnt vmcnt(0)" ::: "memory");
    __syncthreads();
    if (threadIdx.x == 0) {
        unsigned* bar = b.bar;
        __builtin_amdgcn_s_waitcnt(0);
        unsigned nloc = b.st[0], nx = b.st[1];
        if (nloc == 0u) { xcd_barrier_complete(bar, b.x, nloc, nx); b.st[0] = nloc; b.st[1] = nx; }
        const unsigned old = xb_add(&bar[XB_XSUB(b.x)], 1u);
        const unsigned gen = old / nloc;
        if (old + 1u == (gen + 1u) * nloc) {
            __builtin_amdgcn_fence(__ATOMIC_RELEASE, "agent");
            asm volatile("s_waitcnt vmcnt(0)" ::: "memory");
            const unsigned og = xb_add(&bar[XB_TOP], 1u);
            const unsigned tg = og / nx;
            if (og + 1u == (tg + 1u) * nx) xb_add(&bar[XB_TOPGEN], 1u);
            else XB_SPIN(xb_ld(&bar[XB_TOPGEN]) == tg, bar);
            __builtin_amdgcn_fence(__ATOMIC_ACQUIRE, "agent");
            xb_add(&bar[XB_XGEN(b.x)], 1u);
            asm volatile("s_waitcnt vmcnt(0)" ::: "memory");
        } else {
            XB_SPIN(xb_ld(&bar[XB_XGEN(b.x)]) == gen, bar);
            __builtin_amdgcn_fence(__ATOMIC_ACQUIRE, "agent");
            asm volatile("s_waitcnt vmcnt(0)" ::: "memory");
        }
    }
    __syncthreads();
}

__device__ __forceinline__ void transpose_item(const float* W, const float* g  , int K, int N, bf16* WT, LAS float* scr, int kb, int nb, int lane) {
    const int k0 = 64 * kb, n0 = 32 * nb;
#pragma unroll 8
    for (int i = 0; i < 32; ++i) { const int kk = 2 * i + (lane >> 5); const float gv = g ? g[k0 + kk] : 1.f; scr[kk * 33 + (lane & 31)] = W[(size_t)(k0 + kk) * N + n0 + (lane & 31)] * gv; }
    LDS_WAIT(); asm volatile("" ::: "memory");
    const int c = lane & 7;
#pragma unroll
    for (int j = 0; j < 4; ++j) { const int n = (lane >> 3) + 8 * j; const LAS float* s = scr + (8 * c) * 33 + n;
        v4u o; o.x = pk2(s[0 * 33], s[1 * 33]); o.y = pk2(s[2 * 33], s[3 * 33]); o.z = pk2(s[4 * 33], s[5 * 33]); o.w = pk2(s[6 * 33], s[7 * 33]);
        *(GAS v4u*)(WT + (size_t)(n0 + n) * K + k0 + 8 * c) = o; }
    LDS_WAIT(); asm volatile("" ::: "memory");
}
__device__ __forceinline__ void transpose_tensor(const float* W, const float* g, int gstep, int nl, int K, int N, bf16* WT, LAS float* scr, int gw, int NGW, int lane) {
    const int nblk = N / 32, per = (K / 64) * nblk, total = nl * per;
    for (int it = gw; it < total; it += NGW) { const int l = it / per, r = it - l * per;
        transpose_item(W + (size_t)l * K * N, g ? g + (size_t)l * gstep : nullptr, K, N, WT + (size_t)l * K * N, scr, r / nblk, r % nblk, lane); }
}
__device__ __forceinline__ void rms_row_to_bf16(const float* xrow, const float* g, bf16* orow, int lane) {
    const GAS f32x4* xr = (const GAS f32x4*)xrow + lane; const GAS f32x4* gr = (const GAS f32x4*)g + lane;
    f32x4 v[8]; float s = 0.f;
#pragma unroll
    for (int j = 0; j < 8; ++j) { v[j] = xr[64 * j]; s += (v[j].x * v[j].x + v[j].y * v[j].y) + (v[j].z * v[j].z + v[j].w * v[j].w); }
    const float rstd = 1.0f / sqrtf(wave_sum(s) * (1.f / DM) + RMS_EPS);
    GAS v2u* o8 = (GAS v2u*)orow + lane;
#pragma unroll
    for (int j = 0; j < 8; ++j) { const f32x4 gv = gr[64 * j]; v2u o; o.x = pk2(v[j].x * rstd * gv.x, v[j].y * rstd * gv.y); o.y = pk2(v[j].z * rstd * gv.z, v[j].w * rstd * gv.w); o8[64 * j] = o; }
}
__device__ __forceinline__ void row_to_bf16_ss(const float* xrow, bf16* orow, u64* ss, int lane) {
    const GAS f32x4* xr = (const GAS f32x4*)xrow + lane; f32x4 v[8]; float s = 0.f;
#pragma unroll
    for (int j = 0; j < 8; ++j) { v[j] = xr[64 * j]; s += (v[j].x * v[j].x + v[j].y * v[j].y) + (v[j].z * v[j].z + v[j].w * v[j].w); }
    s = wave_sum(s);
    GAS v2u* o8 = (GAS v2u*)orow + lane;
#pragma unroll
    for (int j = 0; j < 8; ++j) { v2u o; o.x = pk2(v[j].x, v[j].y); o.y = pk2(v[j].z, v[j].w); o8[64 * j] = o; }
    if (lane == 0) *ss = (u64)(s * SS_SCALE);
}
__device__ __forceinline__ void norm_phase(const float* x0, const float* x1, int sub1, const float* g, bf16* H, int gw, int NGW, int lane) {
    for (int m = gw; m < MTOK; m += NGW) { const float* xr = (m < S_P) ? x0 + (size_t)m * DM : x1 + (size_t)(m - sub1) * DM; rms_row_to_bf16(xr, g, H + (size_t)m * DM, lane); }
}
__device__ __forceinline__ void merge_phase(const bf16* OG, const float* LSE, bf16* O, int gtid, int NT) {
    for (int idx = gtid; idx < MTOK * (DM / 8); idx += NT) {
        const int m = idx >> 8, col = (idx & 255) * 8, h = col >> 7;
        const float l0 = LSE[(size_t)m * 16 + h], l1 = LSE[(size_t)MTOK * 16 + (size_t)m * 16 + h], l2 = LSE[(size_t)2 * MTOK * 16 + (size_t)m * 16 + h];
        const float mx = fmaxf(l0, fmaxf(l1, l2)); float w0 = __expf(l0 - mx), w1 = __expf(l1 - mx), w2 = __expf(l2 - mx); const float inv = 1.f / (w0 + w1 + w2); w0 *= inv; w1 *= inv; w2 *= inv;
        const size_t off = (size_t)m * DM + col;
        const v4u a = *(const GAS v4u*)(OG + off), b = *(const GAS v4u*)(OG + (size_t)MTOK * DM + off), c = *(const GAS v4u*)(OG + (size_t)2 * MTOK * DM + off);
        v4u o;
#pragma unroll
        for (int e = 0; e < 4; ++e) { const float lo = w0 * bflo(a[e]) + w1 * bflo(b[e]) + w2 * bflo(c[e]), hi = w0 * bfhi(a[e]) + w1 * bfhi(b[e]) + w2 * bfhi(c[e]); o[e] = pk2(lo, hi); }
        *(GAS v4u*)(O + off) = o;
    }
}

__device__ const unsigned char T5B[3][132] = {
 {11,11,11,11,11,11,11,11,11,11,11,11,11,11,11,10,10,10,10,10,10,10,10,10,10,10,10,10,10,10,10,10,10,10,10,10,10,10,9,9,9,9,9,9,9,9,9,9,9,9,8,8,8,8,8,8,8,7,6,5,4,3,2,1,0,17,18,19,20,21,22,23,24,24,24,24,24,24,24,25,25,25,25,25,25,25,25,25,25,25,25,26,26,26,26,26,26,26,26,26,26,26,26,26,26,26,26,26,26,26,26,26,26,26,27,27,27,27,27,27,27,27,27,27,27,27,27,27,27,0,0,0},
 {13,13,13,13,13,13,13,13,13,13,13,13,13,13,13,13,13,13,13,13,13,13,13,12,12,12,12,12,12,12,12,12,12,12,12,12,12,12,12,12,12,12,11,11,11,11,11,11,11,11,11,11,10,10,10,10,10,10,9,9,9,8,8,4,0,20,24,24,25,25,25,26,26,26,26,26,26,27,27,27,27,27,27,27,27,27,27,28,28,28,28,28,28,28,28,28,28,28,28,28,28,28,28,28,28,28,29,29,29,29,29,29,29,29,29,29,29,29,29,29,29,29,29,29,29,29,29,29,29,0,0,0},
 {15,15,15,15,15,15,15,15,15,15,15,15,15,15,15,15,15,15,15,15,15,15,15,15,15,15,15,15,15,15,14,14,14,14,14,14,14,14,14,14,14,14,14,14,14,13,13,13,13,13,13,13,13,13,12,12,12,12,12,11,11,10,10,9,0,25,26,26,27,27,28,28,28,28,28,29,29,29,29,29,29,29,29,29,30,30,30,30,30,30,30,30,30,30,30,30,30,30,30,31,31,31,31,31,31,31,31,31,31,31,31,31,31,31,31,31,31,31,31,31,31,31,31,31,31,31,31,31,31,0,0,0}};

struct NaiveNA {
    static constexpr int NHEADS = NHEAD, NCAND = 128;
    const bf16* Q; const bf16* K; const bf16* V; int ld; const float* qn; const float* kn; const float* rpb  ; bf16* O; int ldo; float* lse;
    __device__ __forceinline__ void cand(int m, int h, int j, int& ktok, float& bias, bool& valid) const {
        int sb, len; seq_of(m, sb, len); const int pos = m - sb, rows = len >> 6, r = pos >> 6, c = pos & 63;
        int rs = r - 4; rs = rs < 0 ? 0 : (rs > rows - 8 ? rows - 8 : rs); int cs = c - 8; cs = cs < 0 ? 0 : (cs > 48 ? 48 : cs);
        const int kr = rs + (j >> 4), kc = cs + (j & 15); ktok = sb + kr * 64 + kc;
        int dc = kc - c; dc = dc < -15 ? -15 : (dc > 15 ? 15 : dc);
        bias = rpb[(h * 15 + (kr - r + 7)) * 31 + dc + 15]; valid = j < NCAND;
        if (!valid) { ktok = m; bias = 0.f; }
    }
};
struct NaiveDil {
    static constexpr int NHEADS = NHEAD, NCAND = 129;
    const bf16* Q; const bf16* K; const bf16* V; int ld; const float* qn; const float* kn; const float* t5  ; int g, dil; bf16* O; int ldo; float* lse;
    __device__ __forceinline__ void cand(int m, int h, int j, int& ktok, float& bias, bool& valid) const {
        int sb, len; seq_of(m, sb, len); const int pos = m - sb, t = pos / dil, rho = pos - t * dil, L = len / dil;
        const int kt = t + j - 64; valid = (j < NCAND) && kt >= 0 && kt < L; ktok = valid ? sb + kt * dil + rho : m;
        bias = valid ? t5[(int)T5B[g][j] * 48 + g * 16 + h] : 0.f;
    }
};
struct NaiveX {
    static constexpr int NHEADS = XHEAD, NCAND = 256;
    const bf16* Q; const bf16* K; const bf16* V; int ld  ; const float* qn; const float* kn; bf16* O; int ldo; float* lse; int ldq;
    __device__ __forceinline__ void cand(int m, int h, int j, int& ktok, float& bias, bool& valid) const {
        const int b = m < S_P ? 0 : 1 + ((m - S_P) >> 11); ktok = b * NMEM + j; bias = 0.f; valid = true;
    }
};
template <class P, int LDQ> __device__ __forceinline__ void attn_naive(const P& p, int gw, int NGW, int lane) {
    constexpr int NC = (P::NCAND + 63) / 64;
    for (int task = gw; task < MTOK * P::NHEADS; task += NGW) {
        const int m = task / P::NHEADS, h = task - m * P::NHEADS;
        const unsigned qw = *(const GAS unsigned*)(p.Q + (size_t)m * LDQ + h * HD + 2 * lane);
        float q0 = bflo(qw), q1 = bfhi(qw);
        const float rq = 1.0f / sqrtf(wave_sum(q0 * q0 + q1 * q1) * (1.f / HD) + RMS_EPS);
        q0 *= rq * p.qn[2 * lane] * p.kn[2 * lane] * ATTN_SCALE; q1 *= rq * p.qn[2 * lane + 1] * p.kn[2 * lane + 1] * ATTN_SCALE;
        int kt[NC]; float bias[NC], sc[NC]; bool valid[NC];
#pragma unroll
        for (int c = 0; c < NC; ++c) { p.cand(m, h, lane + 64 * c, kt[c], bias[c], valid[c]); sc[c] = 0.f; }
#pragma unroll
        for (int c = 0; c < NC; ++c) {
            const int nj = (P::NCAND - 64 * c) < 64 ? (P::NCAND - 64 * c) : 64;
            for (int jj = 0; jj < nj; ++jj) {
                const int ktok = __shfl(kt[c], jj);
                const unsigned kw = *(const GAS unsigned*)(p.K + (size_t)ktok * p.ld + h * HD + 2 * lane);
                const float k0 = bflo(kw), k1 = bfhi(kw);
                const float dot = wave_sum(q0 * k0 + q1 * k1), kss = wave_sum(k0 * k0 + k1 * k1);
                const float s = dot * (1.0f / sqrtf(kss * (1.f / HD) + RMS_EPS));
                if (lane == jj) sc[c] = s;
            }
        }
        float mx = -3.0e38f;
#pragma unroll
        for (int c = 0; c < NC; ++c) { sc[c] = valid[c] ? sc[c] + bias[c] : -1e30f; mx = fmaxf(mx, sc[c]); }
        mx = wave_max(mx); float l = 0.f;
#pragma unroll
        for (int c = 0; c < NC; ++c) { sc[c] = valid[c] ? __expf(sc[c] - mx) : 0.f; l += sc[c]; }
        l = wave_sum(l); const float inv = 1.f / l;
        float o0 = 0.f, o1 = 0.f;
#pragma unroll
        for (int c = 0; c < NC; ++c) {
            const int nj = (P::NCAND - 64 * c) < 64 ? (P::NCAND - 64 * c) : 64;
            for (int jj = 0; jj < nj; ++jj) {
                const int ktok = __shfl(kt[c], jj); const float pj = __shfl(sc[c], jj) * inv;
                const unsigned vw = *(const GAS unsigned*)(p.V + (size_t)ktok * p.ld + h * HD + 2 * lane);
                o0 += pj * bflo(vw); o1 += pj * bfhi(vw);
            }
        }
        *(GAS unsigned*)(p.O + (size_t)m * p.ldo + h * HD + 2 * lane) = pk2(o0, o1);
        if (p.lse != nullptr && lane == 0) p.lse[(size_t)m * 16 + h] = mx + __logf(l);
    }
}

namespace at {
using bf16x8 = __attribute__((ext_vector_type(8))) short;
using s16x4  = __attribute__((ext_vector_type(4))) short;
using f32x16 = __attribute__((ext_vector_type(16))) float;
using u32x4  = __attribute__((ext_vector_type(4))) unsigned;
#define KSWZ(row, colB) ((row) * 256 + ((colB) ^ (((row) & 7) << 4)))
#define SBAR() __builtin_amdgcn_sched_barrier(0)
constexpr int SHM_V = 16384, SHM_K = 16384;
constexpr int A_V = 0, A_K = 2 * SHM_V, A_OST = 65536;
constexpr int A_WS = LDSCTL_OFF + 1024, A_GQ = A_WS + 8 * 256, A_TB = A_GQ + 512, A_TB0 = A_TB + 256;
static_assert(A_TB0 + 4 * 640 <= LDS_BYTES, "attention LDS map");
constexpr float NEGM = -1e30f;
__device__ __forceinline__ int crow(int r, int hi) { return (r & 3) + 8 * (r >> 2) + 4 * hi; }
__device__ __forceinline__ unsigned cvtpk(float lo, float hi) { unsigned r; asm volatile("v_cvt_pk_bf16_f32 %0, %1, %2" : "=v"(r) : "v"(lo), "v"(hi)); return r; }
__device__ __forceinline__ float pl32_max(float v) { auto rr = __builtin_amdgcn_permlane32_swap(__float_as_uint(v), __float_as_uint(v), false, false); return fmaxf(__uint_as_float(rr[0]), __uint_as_float(rr[1])); }
__device__ __forceinline__ float pl32_sum(float v) { auto rr = __builtin_amdgcn_permlane32_swap(__float_as_uint(v), __float_as_uint(v), false, false); return __uint_as_float(rr[0]) + __uint_as_float(rr[1]); }
__device__ __forceinline__ int v_st(int k, int c) { const int kk = (k & ~0xC) | ((k & 4) << 1) | ((k & 8) >> 1); return ((kk >> 3) * 4 + (c >> 5)) * 512 + ((kk & 7) * 32 + (c & 31)) * 2; }
__device__ __forceinline__ int v_rd_base(int lane) { return ((lane & 3) << 3) | (((lane >> 2) & 3) << 6) | (((lane >> 4) & 1) << 5) | (((lane >> 5) & 1) << 8); }
constexpr int v_rd_off(int d0, int ks, int half) { return d0 * 512 + ks * 4096 + half * 2048; }
template <int OFF> __device__ __forceinline__ s16x4 tr_read(int vb) { s16x4 r; asm volatile("ds_read_b64_tr_b16 %0, %1 offset:%2" : "=&v"(r) : "v"(vb), "i"(OFF) : "memory"); return r; }
template <int D0, int SKIP = 0> __device__ __forceinline__ void pv_one(f32x16& od, int vb, bf16x8 pa0, bf16x8 pa1, bf16x8 pa2, bf16x8 pa3) {
  s16x4 l0 = {}, h0 = {}, l1 = {}, h1 = {}, l2 = {}, h2 = {}, l3 = {}, h3 = {};
  if (!(SKIP & 1)) { l0 = tr_read<v_rd_off(D0, 0, 0)>(vb); h0 = tr_read<v_rd_off(D0, 0, 1)>(vb); }
  if (!(SKIP & 2)) { l1 = tr_read<v_rd_off(D0, 1, 0)>(vb); h1 = tr_read<v_rd_off(D0, 1, 1)>(vb); }
  if (!(SKIP & 4)) { l2 = tr_read<v_rd_off(D0, 2, 0)>(vb); h2 = tr_read<v_rd_off(D0, 2, 1)>(vb); }
  if (!(SKIP & 8)) { l3 = tr_read<v_rd_off(D0, 3, 0)>(vb); h3 = tr_read<v_rd_off(D0, 3, 1)>(vb); }
  asm volatile("s_waitcnt lgkmcnt(0)" ::: "memory"); SBAR();
#define PK(L, H) (bf16x8){L[0], L[1], L[2], L[3], H[0], H[1], H[2], H[3]}
  if (!(SKIP & 1)) od = __builtin_amdgcn_mfma_f32_32x32x16_bf16(pa0, PK(l0, h0), od, 0, 0, 0);
  if (!(SKIP & 2)) od = __builtin_amdgcn_mfma_f32_32x32x16_bf16(pa1, PK(l1, h1), od, 0, 0, 0);
  if (!(SKIP & 4)) od = __builtin_amdgcn_mfma_f32_32x32x16_bf16(pa2, PK(l2, h2), od, 0, 0, 0);
  if (!(SKIP & 8)) od = __builtin_amdgcn_mfma_f32_32x32x16_bf16(pa3, PK(l3, h3), od, 0, 0, 0);
#undef PK
}
template <int V> struct IC { static constexpr int value = V; };
template <bool NB0 = true, bool NB1 = true> __device__ __forceinline__ void qkt(f32x16& p0, f32x16& p1, const LAS unsigned char* Ks, const LAS unsigned char* qst, const int (&kx)[4]) {
  bf16x8 kb0[2] = {}, kb1[2] = {}, qq[2];
#define QKT_LOAD(d0_, s_) do { const LAS unsigned char* kp_ = Ks + kx[(d0_) & 3] + ((d0_) >> 2) * 128; if (NB0) kb0[s_] = *(const LAS bf16x8*)kp_; if (NB1) kb1[s_] = *(const LAS bf16x8*)(kp_ + 8192); qq[s_] = *(const LAS bf16x8*)(qst + (d0_) * 1024); } while (0)
  QKT_LOAD(0, 0); QKT_LOAD(1, 1);
  SBAR();
#pragma unroll
  for (int d0 = 0; d0 < 8; ++d0) { const int sl = d0 & 1;
    if (NB0) p0 = __builtin_amdgcn_mfma_f32_32x32x16_bf16(kb0[sl], qq[sl], p0, 0, 0, 0);
    if (NB1) p1 = __builtin_amdgcn_mfma_f32_32x32x16_bf16(kb1[sl], qq[sl], p1, 0, 0, 0);
    SBAR();
    if (d0 + 2 < 8) { QKT_LOAD(d0 + 2, sl); SBAR(); } }
#undef QKT_LOAD
}
template <int CTRL> __device__ __forceinline__ float dppf(float v) { return __builtin_bit_cast(float, __builtin_amdgcn_update_dpp(0, __builtin_bit_cast(int, v), CTRL, 0xf, 0xf, true)); }
__device__ __forceinline__ float row16_sum(float v) { v += dppf<0xB1>(v); v += dppf<0x4E>(v); v += dppf<0x141>(v); v += dppf<0x140>(v); return v; }
__device__ __forceinline__ u32x4 knorm(u32x4 w, float epsv) {
  float f[8]; float ss = 0.f;
#pragma unroll
  for (int e = 0; e < 4; ++e) { f[2 * e] = bflo(w[e]); f[2 * e + 1] = bfhi(w[e]); ss += f[2 * e] * f[2 * e] + f[2 * e + 1] * f[2 * e + 1]; }
  ss = row16_sum(ss);
  const float rs = __builtin_amdgcn_rsqf(ss * (1.f / HD) + epsv);
  u32x4 o;
#pragma unroll
  for (int e = 0; e < 4; ++e) o[e] = cvtpk(f[2 * e] * rs, f[2 * e + 1] * rs);
  return o;
}
__device__ __forceinline__ float u64f(u64 v) { return (float)(unsigned)(v >> 32) * 4294967296.f + (float)(unsigned)v; }
__device__ __forceinline__ u32x4 vscale(u32x4 w, float sc) {
  u32x4 o;
#pragma unroll
  for (int e = 0; e < 4; ++e) o[e] = cvtpk(bflo(w[e]) * sc, bfhi(w[e]) * sc);
  return o;
}

struct PolNA {
  static constexpr bool HAS_BIAS = true, HAS_LSE = false, KV_RS = false, KV_PRE = true, Q_PRE = true, Q_PARTS2 = false, MASK_IN_TABLE = false; static constexpr int LVSET = 1; static constexpr int LDQ = NQKV, LDK = NQKV, LDO = DM, NUNITS = 1024, TB_LO = 0, TB_HI = 465;
  const bf16* Q; const bf16* K; const bf16* V; bf16* O; float* lse; const u64* ss; const float* qn; const float* kn; const float* rpb;
  int h, sb, r0, rows, kr0, T;
  __device__ __forceinline__ static int rs_of(int r, int rows) { int x = r - 4; return x < 0 ? 0 : (x > rows - 8 ? rows - 8 : x); }
  __device__ __forceinline__ void decode(int u) { h = u & 15; const int blk = u >> 4;
    if (blk < 32) { sb = 0; rows = 128; r0 = 4 * blk; } else { sb = S_P + ((blk - 32) >> 3) * S_S; rows = 32; r0 = 4 * ((blk - 32) & 7); }
    kr0 = rs_of(r0, rows); T = rs_of(r0 + 3, rows) + 8 - kr0; }
  __device__ __forceinline__ int qbase(int p) const { return sb + (r0 + p) * 64; }
  __device__ __forceinline__ int kbase(int t) const { return sb + (kr0 + t) * 64; }
  __device__ __forceinline__ int stride() const { return 1; }
  __device__ __forceinline__ bool first_group() const { return true; }
  __device__ __forceinline__ size_t q2off() const { return 0; }
  __device__ __forceinline__ bool active(int p, int t) const { const int rel = kr0 + t - rs_of(r0 + p, rows); return rel >= 0 && rel <= 7; }
  __device__ __forceinline__ void bias_params(int p, int t, int i, int& tboff, int& lo, int& hi_) const { tboff = (kr0 + t - (r0 + p) + 7) * 31 + 15; int cs = i - 8; cs = cs < 0 ? 0 : (cs > 48 ? 48 : cs); lo = cs - i; hi_ = lo + 15; }
  __device__ __forceinline__ int tb_pre(int x) const { return x < 465 ? x : 464; }
  __device__ __forceinline__ float tb_req(int i) const { return rpb[h * 465 + i]; }
  __device__ __forceinline__ float tb_fin(int, float v) const { return v * LOG2E; }
  __device__ __forceinline__ int live_class(int, int, int odd) const { return odd ? 2 : 1; }
};
struct PolDil {
  static constexpr bool HAS_BIAS = true, HAS_LSE = true, KV_RS = false, KV_PRE = true, Q_PRE = true, Q_PARTS2 = false, MASK_IN_TABLE = true; static constexpr int LVSET = 2; static constexpr int LDQ = NQKV, LDK = NQKV, LDO = DM, NUNITS = 1024, TB_LO = -64, TB_HI = 192;
  const bf16* Q; const bf16* K; const bf16* V; bf16* O; float* lse; const u64* ss; const float* qn; const float* kn; const float* t5; int g, dil;
  int h, sb, rho, nb0, kbfirst, T; bool caseB;
  __device__ __forceinline__ void decode(int u) { h = u & 15; const int chunk = u >> 4; int len, c;
    if (chunk < 32) { sb = 0; len = S_P; c = chunk; } else { sb = S_P + ((chunk - 32) >> 3) * S_S; len = S_S; c = (chunk - 32) & 7; }
    const int nblk = (len / dil) >> 6;
    if (nblk >= 4) { caseB = false; const int per = nblk >> 2; rho = c / per; nb0 = 4 * (c - rho * per); kbfirst = nb0 > 0 ? nb0 - 1 : 0; const int kblast = (nb0 + 4 < nblk) ? nb0 + 4 : nblk - 1; T = kblast - kbfirst + 1; }
    else { caseB = true; rho = 2 * c; nb0 = 0; kbfirst = 0; T = 4; } }
  __device__ __forceinline__ int qbase(int p) const { return caseB ? sb + (p & 1) * 64 * dil + rho + (p >> 1) : sb + (nb0 + p) * 64 * dil + rho; }
  __device__ __forceinline__ int kbase(int t) const { return caseB ? sb + (t & 1) * 64 * dil + rho + (t >> 1) : sb + (kbfirst + t) * 64 * dil + rho; }
  __device__ __forceinline__ int stride() const { return dil; }
  __device__ __forceinline__ bool first_group() const { return g == 0; }
  __device__ __forceinline__ size_t q2off() const { return 0; }
  __device__ __forceinline__ int delta(int p, int t) const { return caseB ? ((t >> 1) - (p >> 1)) * 1024 + (t & 1) - (p & 1) : kbfirst + t - (nb0 + p); }
  __device__ __forceinline__ bool active(int p, int t) const { const int d = delta(p, t); return d >= -1 && d <= 1; }
  __device__ __forceinline__ void bias_params(int p, int t, int i, int& tboff, int& lo, int& hi_) const { const int d = delta(p, t); tboff = 64 + 64 * d; lo = -64 - 64 * d; hi_ = 64 - 64 * d; }
  __device__ __forceinline__ int tb_pre(int x) const { return (int)T5B[g][(x >= 0 && x <= 128) ? x : 0] * 48 + g * 16; }
  __device__ __forceinline__ float tb_req(int i) const { return t5[i + h]; }
  __device__ __forceinline__ float tb_fin(int x, float v) const { return (x >= 0 && x <= 128) ? v * LOG2E : NEGM; }
  __device__ __forceinline__ int live_class(int p, int t, int odd) const { const int d = delta(p, t); return (odd && d == -1) ? 3 : ((!odd && d == 1) ? 4 : 0); }
};
struct PolX {
  static constexpr bool HAS_BIAS = false, HAS_LSE = false, KV_RS = false, KV_PRE = false, Q_PRE = false, Q_PARTS2 = true, MASK_IN_TABLE = false; static constexpr int LVSET = 0; static constexpr int LDQ = 512, LDK = 1024, LDO = 512, NUNITS = 256, TB_LO = 0, TB_HI = 0;
  const bf16* Q; const bf16* K; const bf16* V; bf16* O; float* lse; const u64* ss; const float* qn; const float* kn;
  int h, q0, mb, T;
  __device__ __forceinline__ void decode(int u) { h = u & 3; q0 = (u >> 2) * 256; mb = q0 < S_P ? 0 : 1 + ((q0 - S_P) >> 11); T = 4; }
  __device__ __forceinline__ int qbase(int p) const { return q0 + p * 64; }
  __device__ __forceinline__ int kbase(int t) const { return mb * NMEM + t * 64; }
  __device__ __forceinline__ int stride() const { return 1; }
  __device__ __forceinline__ bool first_group() const { return true; }
  __device__ __forceinline__ size_t q2off() const { return (size_t)(WS_XQ2 - WS_XQ) / 2; }
  __device__ __forceinline__ bool active(int, int) const { return true; }
  __device__ __forceinline__ void bias_params(int, int, int, int& tboff, int& lo, int& hi_) const { tboff = 0; lo = 0; hi_ = 0; }
  __device__ __forceinline__ int tb_pre(int) const { return 0; }
  __device__ __forceinline__ float tb_req(int) const { return 0.f; }
  __device__ __forceinline__ float tb_fin(int, float) const { return 0.f; }
  __device__ __forceinline__ int live_class(int, int, int) const { return 0; }
};

template <class P> __device__ __forceinline__ void attn_phase(P pol, LAS unsigned char* L, int G) {
  int tid_l = threadIdx.x; asm volatile("" : "+v"(tid_l));
  const int tid = tid_l, lane = tid & 63, r32 = lane & 31, hi = lane >> 5; const int wid = __builtin_amdgcn_readfirstlane(tid >> 6);
  const int pr = wid >> 1, qi = 32 * (wid & 1) + r32;
  LAS unsigned char* const Vl = L + A_V; LAS unsigned char* const Kl = L + A_K;
  LAS float* const wsf = (LAS float*)(L + A_WS) + wid * 64; LAS float* const gq = (LAS float*)(L + A_GQ); LAS float* const tb = (LAS float*)(L + A_TB0);
  LAS unsigned char* const ost = L + A_OST + wid * 8192;
  const int sr = tid >> 4, sc = (tid & 15) * 8, vst0 = v_st(sr, sc), vst1 = vst0 + 8192, kst0 = KSWZ(sr, sc * 2), kst1 = kst0 + 8192;
  const int vb0 = (int)(unsigned)(uintptr_t)Vl + v_rd_base(lane);
  int kx[4];
#pragma unroll
  for (int k = 0; k < 4; ++k) kx[k] = KSWZ(r32, (k * 16 + hi * 8) * 2);
  if (!P::Q_PRE && tid < HD) gq[tid] = pol.qn[tid] * pol.kn[tid] * (ATTN_SCALE * LOG2E);
  __syncthreads();
  static_assert(P::TB_HI - P::TB_LO <= NWAVES * 64, "one bias table entry per thread");
  const int tbi = P::HAS_BIAS ? pol.tb_pre(P::TB_LO + tid) : 0; (void)tbi;
  for (int u = blockIdx.x; u < P::NUNITS; u += G) {
    pol.decode(u);
    const int T = pol.T, hoff = pol.h * HD;
    const int qb = __builtin_amdgcn_readfirstlane(pol.qbase(pr)), strd = pol.stride();
    u32x4 ks0, ks1, vs0, vs1; u64 rs0 = 0, rs1 = 0;
    const unsigned so0 = (unsigned)(sr * strd * P::LDK + hoff + sc), so1 = so0 + (unsigned)(32 * strd * P::LDK);
#define SLOAD(t) do { const size_t tb_ = (size_t)__builtin_amdgcn_readfirstlane(pol.kbase(t)) * P::LDK; const bf16* Kt_ = pol.K + tb_; const bf16* Vt_ = pol.V + tb_; \
      ks0 = *(const GAS u32x4*)(Kt_ + so0); ks1 = *(const GAS u32x4*)(Kt_ + so1); vs0 = *(const GAS u32x4*)(Vt_ + so0); vs1 = *(const GAS u32x4*)(Vt_ + so1); \
      if (P::KV_RS) { const u64* sp_ = pol.ss + __builtin_amdgcn_readfirstlane(pol.kbase(t)); rs0 = sp_[sr * strd]; rs1 = sp_[(32 + sr) * strd]; } } while (0)
#define SWRITE(b) do { float e0_ = RMS_EPS, e1_ = RMS_EPS; \
      if (P::KV_RS) { const float v0_ = u64f(rs0) * SS_INV + RMS_EPS, v1_ = u64f(rs1) * SS_INV + RMS_EPS; e0_ = RMS_EPS * v0_; e1_ = RMS_EPS * v1_; \
        vs0 = vscale(vs0, __builtin_amdgcn_rsqf(v0_)); vs1 = vscale(vs1, __builtin_amdgcn_rsqf(v1_)); } \
      *(LAS u32x4*)(Vl + (b) * SHM_V + vst0) = vs0; *(LAS u32x4*)(Vl + (b) * SHM_V + vst1) = vs1; \
      *(LAS u32x4*)(Kl + (b) * SHM_K + kst0) = P::KV_PRE ? ks0 : knorm(ks0, e0_); *(LAS u32x4*)(Kl + (b) * SHM_K + kst1) = P::KV_PRE ? ks1 : knorm(ks1, e1_); } while (0)
    SLOAD(0);
    const float tbv = P::HAS_BIAS ? pol.tb_req(tbi) : 0.f;
    bf16x8 qf[8];
    if (P::Q_PRE) {
      const bf16* Qp = pol.Q + (size_t)qb * P::LDQ + (unsigned)(qi * strd * P::LDQ + hoff + hi * 8);
#pragma unroll
      for (int d0 = 0; d0 < 8; ++d0) qf[d0] = __builtin_bit_cast(bf16x8, *(const GAS u32x4*)(Qp + d0 * 16));
    } else { const bf16* Qp = pol.Q + (size_t)qb * P::LDQ + (unsigned)(qi * strd * P::LDQ + hoff + hi * 8);
      const u64 ssq = pol.ss[qb + qi * strd];
      u32x4 qw[8]; float ss = 0.f;
#pragma unroll
      for (int d0 = 0; d0 < 8; ++d0) qw[d0] = *(const GAS u32x4*)(Qp + d0 * 16);
      if (P::Q_PARTS2) {
#pragma unroll
        for (int d0 = 0; d0 < 8; ++d0) { const u32x4 q2 = *(const GAS u32x4*)(Qp + pol.q2off() + d0 * 16);
#pragma unroll
          for (int e = 0; e < 4; ++e) qw[d0][e] = cvtpk(bflo(qw[d0][e]) + bflo(q2[e]), bfhi(qw[d0][e]) + bfhi(q2[e])); } }
      const float varq = u64f(ssq) * SS_INV + RMS_EPS;
#pragma unroll
      for (int d0 = 0; d0 < 8; ++d0)
#pragma unroll
        for (int e = 0; e < 4; ++e) { const float a = bflo(qw[d0][e]), b = bfhi(qw[d0][e]); ss += a * a + b * b; }
      ss = pl32_sum(ss);
      const float rq = __builtin_amdgcn_rsqf(ss * (1.f / HD) + RMS_EPS * varq);
#pragma unroll
      for (int d0 = 0; d0 < 8; ++d0) { const f32x4 g0 = *(const LAS f32x4*)(gq + d0 * 16 + hi * 8), g1 = *(const LAS f32x4*)(gq + d0 * 16 + hi * 8 + 4); u32x4 w;
        w[0] = cvtpk(bflo(qw[d0][0]) * rq * g0[0], bfhi(qw[d0][0]) * rq * g0[1]); w[1] = cvtpk(bflo(qw[d0][1]) * rq * g0[2], bfhi(qw[d0][1]) * rq * g0[3]);
        w[2] = cvtpk(bflo(qw[d0][2]) * rq * g1[0], bfhi(qw[d0][2]) * rq * g1[1]); w[3] = cvtpk(bflo(qw[d0][3]) * rq * g1[2], bfhi(qw[d0][3]) * rq * g1[3]);
        qf[d0] = __builtin_bit_cast(bf16x8, w); } }
    const LAS unsigned char* const qst = ost + lane * 16;
#pragma unroll
    for (int d0 = 0; d0 < 8; ++d0) *(LAS bf16x8*)(ost + d0 * 1024 + lane * 16) = qf[d0];
    if (P::HAS_BIAS) { const int x = P::TB_LO + tid; if (x < P::TB_HI) tb[x] = pol.tb_fin(x, tbv); }
    SWRITE(0);
    __syncthreads();
    constexpr float m_reg = 0.f; float l_reg = 0.f; f32x16 o[4] = {};
#define PK4(Pv, BASE, OUT) do { unsigned a0 = cvtpk(Pv[BASE + 0], Pv[BASE + 1]), a1 = cvtpk(Pv[BASE + 2], Pv[BASE + 3]);   \
    unsigned b0_ = cvtpk(Pv[BASE + 4], Pv[BASE + 5]), b1_ = cvtpk(Pv[BASE + 6], Pv[BASE + 7]);                              \
    auto r0_ = __builtin_amdgcn_permlane32_swap(a0, b0_, false, false); auto r1_ = __builtin_amdgcn_permlane32_swap(a1, b1_, false, false); \
    u32x4 w_ = {r0_[0], r1_[0], r0_[1], r1_[1]}; OUT = __builtin_bit_cast(bf16x8, w_); } while (0)
#define PIN8(a) asm volatile("" : "+v"(a[0]), "+v"(a[1]), "+v"(a[2]), "+v"(a[3]), "+v"(a[4]), "+v"(a[5]), "+v"(a[6]), "+v"(a[7]))
    for (int t = 0; t < T; ++t) {
      const int b = t & 1;
      if (t + 1 < T) SLOAD(t + 1);
      if (pol.active(pr, t)) {
        auto body = [&](auto lvc) {
          constexpr int LV = decltype(lvc)::value;
          constexpr bool NB0 = LV != 3, NB1 = LV != 4;
          auto live0 = [](int rr) constexpr { return LV == 3 ? false : (LV == 2 ? rr >= 12 : true); };
          auto live1 = [](int rr) constexpr { return LV == 4 ? false : (LV == 1 ? rr < 4 : true); };
          f32x16 p0 = {}, p1 = {};
          int tboff = 0, lo = 0, hi_ = 0; if (P::HAS_BIAS) pol.bias_params(pr, t, qi, tboff, lo, hi_);
          if (P::HAS_BIAS) {
            const LAS unsigned char* tbp = (const LAS unsigned char*)tb + 4 * (tboff + 4 * hi - qi);
#pragma unroll
            for (int rr = 0; rr < 16; ++rr) { const int cj = (rr & 3) + 8 * (rr >> 2); if (live0(rr)) p0[rr] = *(const LAS float*)(tbp + 4 * cj); if (live1(rr)) p1[rr] = *(const LAS float*)(tbp + 4 * (cj + 32)); }
          }
          qkt<NB0, NB1>(p0, p1, Kl + b * SHM_K, qst, kx);
          if (P::HAS_BIAS && !P::MASK_IN_TABLE) {
            const int dbase = 4 * hi - qi - lo; const unsigned width = (unsigned)(hi_ - lo);
#pragma unroll
            for (int rr = 0; rr < 16; ++rr) { const int cj = (rr & 3) + 8 * (rr >> 2);
              if (live0(rr)) p0[rr] = ((unsigned)(dbase + cj) <= width) ? p0[rr] : NEGM; if (live1(rr)) p1[rr] = ((unsigned)(dbase + cj + 32) <= width) ? p1[rr] : NEGM; }
          }
          float ps = 0.f;
#pragma unroll
          for (int r = 0; r < 16; ++r) { if (live0(r)) { p0[r] = __builtin_amdgcn_exp2f(p0[r]); ps += p0[r]; } if (live1(r)) { p1[r] = __builtin_amdgcn_exp2f(p1[r]); ps += p1[r]; } }
          ps = pl32_sum(ps);
          l_reg += ps;
#define PKG(Pv, R0, LIVE) ((LIVE) ? cvtpk(Pv[R0], Pv[(R0) + 1]) : 0u)
#define PK4L(Pv, BASE, LVF, OUT) do { unsigned a0 = PKG(Pv, BASE + 0, LVF(BASE + 0)), a1 = PKG(Pv, BASE + 2, LVF(BASE + 2)), b0_ = PKG(Pv, BASE + 4, LVF(BASE + 4)), b1_ = PKG(Pv, BASE + 6, LVF(BASE + 6)); \
            auto r0_ = __builtin_amdgcn_permlane32_swap(a0, b0_, false, false); auto r1_ = __builtin_amdgcn_permlane32_swap(a1, b1_, false, false); \
            u32x4 w_ = {r0_[0], r1_[0], r0_[1], r1_[1]}; OUT = __builtin_bit_cast(bf16x8, w_); } while (0)
          bf16x8 pa0 = {}, pa1 = {}, pa2 = {}, pa3 = {};
          constexpr int SK = (!live0(0) && !live0(4) ? 1 : 0) | (!live0(8) && !live0(12) ? 2 : 0) | (!live1(0) && !live1(4) ? 4 : 0) | (!live1(8) && !live1(12) ? 8 : 0);
          if (!(SK & 1)) PK4L(p0, 0, live0, pa0); if (!(SK & 2)) PK4L(p0, 8, live0, pa1); if (!(SK & 4)) PK4L(p1, 0, live1, pa2); if (!(SK & 8)) PK4L(p1, 8, live1, pa3);
#undef PK4L
#undef PKG
          SBAR();
          const int vb = vb0 + b * SHM_V;
          pv_one<0, SK>(o[0], vb, pa0, pa1, pa2, pa3); pv_one<1, SK>(o[1], vb, pa0, pa1, pa2, pa3); pv_one<2, SK>(o[2], vb, pa0, pa1, pa2, pa3); pv_one<3, SK>(o[3], vb, pa0, pa1, pa2, pa3);
        };
        const int lvcls = pol.live_class(pr, t, wid & 1);
        if constexpr (P::LVSET == 1) { if (lvcls == 1) body(IC<1>{}); else body(IC<2>{}); }
        else if constexpr (P::LVSET == 2) { if (lvcls == 3) body(IC<3>{}); else if (lvcls == 4) body(IC<4>{}); else body(IC<0>{}); }
        else body(IC<0>{});
      }
      if (t + 1 < T) SWRITE(b ^ 1);
      __syncthreads();
    }
#undef PK4
#undef PIN8
    const bool mfirst = !P::HAS_LSE || pol.first_group();
    u32x4 pvo[8]; float lse_p = 0.f; float* const lp = P::HAS_LSE ? pol.lse + (size_t)(qb + qi * strd) * 16 + pol.h : nullptr;
    if (P::HAS_LSE) { lse_p = *lp;
#pragma unroll
      for (int it = 0; it < 8; ++it) { const int row = it * 4 + (lane >> 4), ch = lane & 15;
        pvo[it] = *(const GAS u32x4*)(pol.O + (size_t)qb * P::LDO + (unsigned)((32 * (wid & 1) + row) * strd * P::LDO + hoff + ch * 8)); } }
    if (hi == 0) wsf[32 + r32] = l_reg;
    asm volatile("s_waitcnt lgkmcnt(0)" ::: "memory");
#pragma unroll
    for (int r = 0; r < 16; r += 2) { const int or0 = crow(r, hi), or1 = crow(r + 1, hi); const float rl0 = __builtin_amdgcn_rcpf(wsf[32 + or0]), rl1 = __builtin_amdgcn_rcpf(wsf[32 + or1]);
#pragma unroll
      for (int d0 = 0; d0 < 4; ++d0) { const unsigned w = cvtpk(o[d0][r] * rl0, o[d0][r + 1] * rl1);
        *(LAS unsigned short*)(ost + (or0 * 128 + d0 * 32 + r32) * 2) = (unsigned short)w; *(LAS unsigned short*)(ost + (or1 * 128 + d0 * 32 + r32) * 2) = (unsigned short)(w >> 16); } }
    asm volatile("s_waitcnt lgkmcnt(0)" ::: "memory");
    if (P::HAS_LSE) {
      float lse_n = (m_reg + __builtin_amdgcn_logf(l_reg)) * 0.6931471805599453f;
      if (!mfirst) { if (hi == 0) { const float Lm = fmaxf(lse_p, lse_n);
          const float wp = __expf(lse_p - Lm), wn = __expf(lse_n - Lm), sm = wp + wn, inv = 1.0f / sm; wsf[r32] = wp * inv; wsf[32 + r32] = wn * inv; *lp = Lm + __logf(sm); }
        asm volatile("s_waitcnt lgkmcnt(0)" ::: "memory"); }
      else { if (hi == 0) *lp = lse_n; }
#pragma unroll
      for (int it = 0; it < 8; ++it) { const int row = it * 4 + (lane >> 4), ch = lane & 15;
        u32x4 v = *(const LAS u32x4*)(ost + row * 256 + ch * 16);
        bf16* gp = pol.O + (size_t)qb * P::LDO + (unsigned)((32 * (wid & 1) + row) * strd * P::LDO + hoff + ch * 8);
        if (!mfirst) { const u32x4 pv_ = pvo[it]; const float wp = wsf[row], wn = wsf[32 + row];
#pragma unroll
          for (int e = 0; e < 4; ++e) v[e] = cvtpk(bflo(pv_[e]) * wp + bflo(v[e]) * wn, bfhi(pv_[e]) * wp + bfhi(v[e]) * wn); }
        *(GAS u32x4*)gp = v; }
    } else {
#pragma unroll
      for (int it = 0; it < 8; ++it) { const int row = it * 4 + (lane >> 4), ch = lane & 15;
        const u32x4 v = *(const LAS u32x4*)(ost + row * 256 + ch * 16);
        *(GAS u32x4*)(pol.O + (size_t)qb * P::LDO + (unsigned)((32 * (wid & 1) + row) * strd * P::LDO + hoff + ch * 8)) = v; }
    }
    asm volatile("s_waitcnt lgkmcnt(0)" ::: "memory");
#undef SLOAD
#undef SWRITE
  }
  __syncthreads();
}
#undef KSWZ
#undef SBAR
}

#ifndef NAIVE_NA
#define NAIVE_NA 0
#endif
#ifndef NAIVE_DIL
#define NAIVE_DIL 0
#endif
#ifndef NAIVE_X
#define NAIVE_X 0
#endif
#ifndef R_PRO
#define R_PRO 1
#endif
#ifndef R_THIN
#define R_THIN 1
#endif
#ifndef R_ATT_NA
#define R_ATT_NA 1
#endif
#ifndef R_ATT_DIL
#define R_ATT_DIL 1
#endif
#ifndef R_ATT_X
#define R_ATT_X 1
#endif
#ifndef R_GQ
#define R_GQ 1
#endif
#ifndef R_GR
#define R_GR 1
#endif
#ifndef R_GU
#define R_GU 1
#endif
#ifndef WGM_QKV
#define WGM_QKV 4
#endif
#ifndef WGM_UP
#define WGM_UP 4
#endif
#ifndef WGM_RES
#define WGM_RES 4
#endif
#ifndef MK_PER_PHASE
#define MK_PER_PHASE 0
#endif
constexpr int NPHASES = 1 + 2 * 8 + 2 * 10;
struct KvOrder {
    int G, c;
    __device__ __forceinline__ bool next(int i, pg8::Unit& u) const { const int L = i * G + c; if (L >= 80) return false; const int l = L / 20, r = L - l * 20; u.pm = l * 5 + (r % 5); u.pn = l * 4 + (r / 5); u.ko = 0; return true; }
    __device__ __forceinline__ void a_ready(const pg8::Unit&) const {}
    __device__ __forceinline__ void done(const pg8::Unit&) const {}
};
struct QxOrder {
    int G, c;
    __device__ __forceinline__ bool next(int i, pg8::Unit& u) const { const int L = i * G + c; if (c < 0 || L >= 256) return false; u.pm = L >> 2; u.pn = (L >> 1) & 1; u.ko = (L & 1) * (DM / 2); return true; }
    __device__ __forceinline__ void a_ready(const pg8::Unit&) const {}
    __device__ __forceinline__ void done(const pg8::Unit&) const {}
};
struct Args { const float* in[25]; float* out; unsigned char* ws; int ph_lo, ph_hi; };
typedef const __attribute__((address_space(4))) Args* kargp;
__global__ void __launch_bounds__(NWAVES * 64, 2) fwd(Args args) {
    extern __shared__ __attribute__((aligned(16))) unsigned char lds[];
    LAS unsigned char* const L = (LAS unsigned char*)lds;
    const int G = gridDim.x;
    { const int t0 = threadIdx.x; for (int u = t0; u < (LDS_BYTES - LDSCTL_OFF) / 4; u += NWAVES * 64) ((LAS unsigned*)(L + LDSCTL_OFF))[u] = 0u; }
    __syncthreads();
    XcdBarrier bar = xcd_barrier_post((unsigned*)(args.ws + WS_CTL) + CW_BAR, (volatile LAS unsigned*)(L + MISC_OFF) + 8);
    const int lo = args.ph_lo, hi = args.ph_hi; int ph = 0;
#define PH_BEGIN if (ph >= lo && ph < hi) { kargp ka = (kargp)__builtin_amdgcn_kernarg_segment_ptr(); asm volatile("" : "+s"(ka)); int tid = threadIdx.x; asm volatile("" : "+v"(tid)); \
        const int lane = tid & 63, wave = __builtin_amdgcn_readfirstlane(tid >> 6), gw = blockIdx.x * NWAVES + wave, NGW = G * NWAVES; (void)lane; (void)gw; (void)NGW; unsigned char* const ws = ka->ws; (void)ws;
#define PH_END   if (ph + 1 < hi) xcd_barrier(bar); } ++ph;
#define WSB(off) ((bf16*)(ws + (off)))

    PH_BEGIN
        LAS float* scr = (LAS float*)(L + RING_OFF + wave * 16384);
        for (int rep_ = 0; rep_ < R_PRO; ++rep_) {
        transpose_tensor(ka->in[8], ka->in[4], 2 * DM, 2, DM, NQKV, WSB(WS_WQKVA), scr, gw, NGW, lane);
        transpose_tensor(ka->in[13], ka->in[4] + DM, 2 * DM, 2, DM, 3 * NQKV, WSB(WS_WQKVB), scr, gw, NGW, lane);
        transpose_tensor(ka->in[12], nullptr, 0, 2, DM, DM, WSB(WS_WOA), scr, gw, NGW, lane);
        transpose_tensor(ka->in[17], nullptr, 0, 2, DM, DM, WSB(WS_WOB), scr, gw, NGW, lane);
        transpose_tensor(ka->in[18], ka->in[5], DM, 4, DM, XHEAD * HD, WSB(WS_WQX), scr, gw, NGW, lane);
        transpose_tensor(ka->in[19], nullptr, 0, 4, DM, 2 * XHEAD * HD, WSB(WS_WKVX), scr, gw, NGW, lane);
        transpose_tensor(ka->in[22], nullptr, 0, 4, XHEAD * HD, DM, WSB(WS_WOX), scr, gw, NGW, lane);
        transpose_tensor(ka->in[23], ka->in[7], DM, 4, DM, DFF, WSB(WS_WUP), scr, gw, NGW, lane);
        transpose_tensor(ka->in[24], nullptr, 0, 4, DFF, DM, WSB(WS_WDN), scr, gw, NGW, lane);
        const float* mem_prompt = ka->in[2]; const float* mem_sample = ka->in[3]; const float* g_mem = ka->in[6]; bf16* MEMN = WSB(WS_OG);
        for (int t = gw; t < 4 * MEMROWS; t += NGW) { const int i = t / MEMROWS, r = t - i * MEMROWS;
            const float* mr = r < NMEM ? mem_prompt + (size_t)r * DM : mem_sample + (size_t)(r - NMEM) * DM;
            rms_row_to_bf16(mr, g_mem + i * DM, MEMN + (size_t)t * DM, lane); }
        { const float* x0 = ka->in[0]; const float* x1 = ka->in[1]; bf16* XB = WSB(WS_H); u64* SS = (u64*)(ws + WS_SS);
          for (int m = gw; m < MTOK; m += NGW) row_to_bf16_ss(m < S_P ? x0 + (size_t)m * DM : x1 + (size_t)(m - S_P) * DM, XB + (size_t)m * DM, SS + m, lane);
          for (int i = blockIdx.x * (NWAVES * 64) + tid; i < 2 * MTOK; i += G * NWAVES * 64) SS[MTOK + i] = 0ull; }
        }
        __syncthreads();
    PH_END
    for (int layer = 0; layer < 4; ++layer) {
        const int li = layer >> 1; const bool odd = (layer & 1) != 0;
        const int ngroups = odd ? 3 : 1;
        for (int step = 0; step <= ngroups; ++step) {
            PH_BEGIN
                if (step > 0) {
                    const int grp = step - 1; bf16* QKV = WSB((grp & 1) ? WS_OG : WS_QKV);
                    if (!odd) {
                        at::PolNA P{}; P.Q = QKV; P.K = QKV + DM; P.V = QKV + 2 * DM; P.O = WSB(WS_O); P.lse = nullptr; P.ss = (const u64*)(ws + WS_SS); P.qn = ka->in[9] + li * HD; P.kn = ka->in[10] + li * HD; P.rpb = ka->in[11] + (size_t)li * 16 * 15 * 31;
                        for (int rep_ = 0; rep_ < R_ATT_NA; ++rep_) at::attn_phase<at::PolNA>(P, L, G);
                    } else { const int dil = grp == 0 ? 1 : (grp == 1 ? 4 : 16);
                        at::PolDil P{}; P.Q = QKV; P.K = QKV + DM; P.V = QKV + 2 * DM; P.O = WSB(WS_O); P.lse = (float*)(ws + WS_LSE);
                        P.ss = (const u64*)(ws + WS_SS); P.qn = ka->in[14] + (li * 3 + grp) * HD; P.kn = ka->in[15] + (li * 3 + grp) * HD; P.t5 = ka->in[16]; P.g = grp; P.dil = dil;
                        for (int rep_ = 0; rep_ < R_ATT_DIL; ++rep_) at::attn_phase<at::PolDil>(P, L, G);
                    }
                }
                if (step < ngroups) {
                    const int grp = step;
                    if (layer > 0 && grp == 0) { u64* SS = (u64*)(ws + WS_SS); for (int i = blockIdx.x * (NWAVES * 64) + tid; i < MTOK; i += G * NWAVES * 64) SS[2 * MTOK + i] = 0ull; }
                    const bf16* Bt = odd ? WSB(WS_WQKVB) + ((size_t)li * 3 + grp) * NQKV * DM : WSB(WS_WQKVA) + (size_t)li * NQKV * DM;
                    int bx_ = (int)blockIdx.x; asm volatile("" : "+s"(bx_));
                    pg8::Gemm g{WSB(WS_H), Bt, MTOK, NQKV, DM}; pg8::StaticOrder S; S.init(MTOK, NQKV, G, bx_, WGM_QKV);
                    LAS float* varl = (LAS float*)(L + LDSCTL_OFF + 1024); LAS float* red = (LAS float*)(L + LDSCTL_OFF + 4096); LAS float* gql = (LAS float*)(L + LDSCTL_OFF + 3072);
                    pg8::Unit u0, u3; const int pm0 = S.next(0, u0) ? u0.pm : -1, pm1 = S.next(3, u3) ? u3.pm : -1;
                    __syncthreads();
                    { const int pmx = tid < 256 ? pm0 : pm1; if (pmx >= 0) varl[tid] = at::u64f(((const u64*)(ws + WS_SS))[pmx * 256 + (tid & 255)]) * SS_INV + RMS_EPS; }
                    if (tid < HD) { const float* qn_ = odd ? ka->in[14] + (li * 3 + grp) * HD : ka->in[9] + li * HD; const float* kn_ = odd ? ka->in[15] + (li * 3 + grp) * HD : ka->in[10] + li * HD;
                        gql[tid] = qn_[tid] * kn_[tid] * (ATTN_SCALE * LOG2E); }
                    __syncthreads();
                    pg8::EpiQKV E{WSB((grp & 1) ? WS_OG : WS_QKV), NQKV, varl, red, pm0, pm1, (const u64*)(ws + WS_SS), gql};
                    for (int rep_ = 0; rep_ < R_GQ; ++rep_) pg8::gemm_phase<pg8::EpiQKV, pg8::StaticOrder, true, true>(L + RING_OFF, g, S, E);
                }
            PH_END
        }
        PH_BEGIN
            float* X = ka->out;
            pg8::Gemm g{WSB(WS_O), (odd ? WSB(WS_WOB) : WSB(WS_WOA)) + (size_t)li * DM * DM, MTOK, DM, DM}; pg8::StaticOrder S; S.init(MTOK, DM, G, (int)blockIdx.x, WGM_RES);
            u64* SS = (u64*)(ws + WS_SS);
            for (int i = blockIdx.x * (NWAVES * 64) + tid; i < MTOK; i += G * NWAVES * 64) SS[i] = 0ull;
            pg8::EpiRes E{WSB(WS_H), nullptr, DM, SS + MTOK, nullptr};
            for (int rep_ = 1; rep_ < R_GR; ++rep_) { pg8::EpiRes E2 = E; E2.outf = (float*)(ws + 960 * MiB); E2.ssout = (u64*)(ws + 8 * MiB); pg8::gemm_phase<pg8::EpiRes, pg8::StaticOrder, true, true>(L + RING_OFF, g, S, E2); }
            pg8::gemm_phase<pg8::EpiRes, pg8::StaticOrder, true, true>(L + RING_OFF, g, S, E);
        PH_END
        PH_BEGIN
            const int nkv = (layer == 0 && G > 160) ? 80 : 0;
            pg8::Gemm g{WSB(WS_H), WSB(WS_WQX) + (size_t)layer * 512 * DM, MTOK, 512, DM / 2, DM}; QxOrder S{G - nkv, (int)blockIdx.x - nkv};
            pg8::EpiBf16<0> E{WSB(WS_XQ), 512, 0, 0, (size_t)(WS_XQ2 - WS_XQ) / 2};
            for (int rep_ = 0; rep_ < R_GU; ++rep_) pg8::gemm_phase<pg8::EpiBf16<0>, QxOrder, true, true>(L + RING_OFF, g, S, E);
            if (layer == 0) {
                pg8::Gemm g2{WSB(WS_OG), WSB(WS_WKVX), 4 * MEMROWS, 4 * 1024, DM}; KvOrder S2{G, (int)blockIdx.x};
                pg8::EpiBf16<0> E2{WSB(WS_KVM), 1024, 1024, 0};
                pg8::gemm_phase<pg8::EpiBf16<0>, KvOrder, true, true>(L + RING_OFF, g2, S2, E2);
            }
        PH_END
        PH_BEGIN
            const bf16* kv = WSB(WS_KVM) + (size_t)layer * MEMROWS * 1024;
#if NAIVE_X
            NaiveX P{WSB(WS_XQ), kv, kv + 512, 1024, ka->in[20] + layer * HD, ka->in[21] + layer * HD, WSB(WS_XO), 512, nullptr, 512};
            attn_naive<NaiveX, 512>(P, gw, NGW, lane);
#else
            at::PolX P{}; P.Q = WSB(WS_XQ); P.K = kv; P.V = kv + 512; P.O = WSB(WS_XO); P.lse = nullptr; P.ss = (const u64*)(ws + WS_SS) + MTOK; P.qn = ka->in[20] + layer * HD; P.kn = ka->in[21] + layer * HD;
            for (int rep_ = 0; rep_ < R_ATT_X; ++rep_) at::attn_phase<at::PolX>(P, L, G);
#endif
        PH_END
        PH_BEGIN
            float* X = ka->out;
            pg8::Gemm g{WSB(WS_XO), WSB(WS_WOX) + (size_t)layer * DM * 512, MTOK, DM, 512}; pg8::StaticOrder S; S.init(MTOK, DM, G, (int)blockIdx.x, WGM_RES);
            u64* SS = (u64*)(ws + WS_SS); pg8::EpiRes E{WSB(WS_H), nullptr, DM, SS + 2 * MTOK, nullptr};
            for (int rep_ = 1; rep_ < R_GR; ++rep_) { pg8::EpiRes E2 = E; E2.outf = (float*)(ws + 960 * MiB); E2.ssout = (u64*)(ws + 8 * MiB); pg8::gemm_phase<pg8::EpiRes, pg8::StaticOrder, true, true>(L + RING_OFF, g, S, E2); }
            pg8::gemm_phase<pg8::EpiRes, pg8::StaticOrder, true, true>(L + RING_OFF, g, S, E);
        PH_END
        PH_BEGIN
            { u64* SS = (u64*)(ws + WS_SS); for (int i = blockIdx.x * (NWAVES * 64) + tid; i < MTOK; i += G * NWAVES * 64) SS[MTOK + i] = 0ull; }
            pg8::Gemm g{WSB(WS_H), WSB(WS_WUP) + (size_t)layer * DFF * DM, MTOK, DFF, DM}; pg8::StaticOrder S; S.init(MTOK, DFF, G, (int)blockIdx.x, WGM_UP);
            pg8::EpiBf16<2> E{WSB(WS_HID), DFF, 0, 0};
            for (int rep_ = 0; rep_ < R_GU; ++rep_) pg8::gemm_phase<pg8::EpiBf16<2>, pg8::StaticOrder, true, true>(L + RING_OFF, g, S, E);
        PH_END
        PH_BEGIN
            float* X = ka->out;
            pg8::Gemm g{WSB(WS_HID), WSB(WS_WDN) + (size_t)layer * DM * DFF, MTOK, DM, DFF}; pg8::StaticOrder S; S.init(MTOK, DM, G, (int)blockIdx.x, WGM_RES);
            u64* SS = (u64*)(ws + WS_SS); pg8::EpiRes E{WSB(WS_H), layer == 3 ? X : nullptr, DM, SS, SS + 2 * MTOK};
            for (int rep_ = 1; rep_ < R_GR; ++rep_) { pg8::EpiRes E2 = E; E2.outf = (float*)(ws + 960 * MiB); E2.ssout = (u64*)(ws + 8 * MiB); pg8::gemm_phase<pg8::EpiRes, pg8::StaticOrder, true, true>(L + RING_OFF, g, S, E2); }
            pg8::gemm_phase<pg8::EpiRes, pg8::StaticOrder, true, true>(L + RING_OFF, g, S, E);
        PH_END
    }
#undef PH_BEGIN
#undef PH_END
#undef WSB
}

extern "C" void kernel_launch(void* const* d_in, const int* in_sizes, int n_in, void* d_out, int out_size, void* d_ws, size_t ws_size, hipStream_t stream) {
    static int grid = 0;
    if (grid == 0) {
        if (n_in != 25 || out_size != MTOK * DM || ws_size < WS_END) { fprintf(stderr, "kernel_launch: unexpected shapes (n_in %d out %d ws %zu need %zu); nothing launched\n", n_in, out_size, ws_size, (size_t)WS_END); grid = -1; return; }
        int dev = 0, cus = 0, per_cu = 0;
        if (hipGetDevice(&dev) != hipSuccess || hipDeviceGetAttribute(&cus, hipDeviceAttributeMultiprocessorCount, dev) != hipSuccess) { grid = -1; return; }
        if (hipFuncSetAttribute((const void*)fwd, hipFuncAttributeMaxDynamicSharedMemorySize, LDS_BYTES) != hipSuccess) { fprintf(stderr, "kernel_launch: hipFuncSetAttribute failed\n"); grid = -1; return; }
        if (hipOccupancyMaxActiveBlocksPerMultiprocessor(&per_cu, (const void*)fwd, NWAVES * 64, LDS_BYTES) != hipSuccess || per_cu < 1) { fprintf(stderr, "kernel_launch: occupancy query says %d blocks per CU\n", per_cu); (void)hipGetLastError(); grid = -1; return; }
        grid = cus;
    }
    if (grid < 0) return;
    (void)hipMemsetAsync((char*)d_ws + WS_CTL, 0, CTL_ZERO_BYTES, stream);
    Args a{};
    for (int i = 0; i < 25; ++i) a.in[i] = (const float*)d_in[i];
    a.out = (float*)d_out; a.ws = (unsigned char*)d_ws;
#if MK_PER_PHASE
    for (int p = 0; p < NPHASES; ++p) { a.ph_lo = p; a.ph_hi = p + 1; hipLaunchKernelGGL(fwd, dim3(grid), dim3(NWAVES * 64), LDS_BYTES, stream, a); }
#else
    a.ph_lo = 0; a.ph_hi = NPHASES;
    hipLaunchKernelGGL(fwd, dim3(grid), dim3(NWAVES * 64), LDS_BYTES, stream, a);
#endif
    const hipError_t le = hipPeekAtLastError();
    if (le != hipSuccess) fprintf(stderr, "kernel_launch: launch failed: %s\n", hipGetErrorName(le));
}
```
